# Optimizing an MI355X kernel written in HIP

```python
import math
import jax, jax.numpy as jnp
from jax import lax
import numpy as np

D_MODEL = 1024
BATCH = 8
SEQ = 4096
DEPTH = 1
DEC_BATCH = 32
DEC_SEQ = 2048
PAST_LEN = 128

HEAD_DIM = 64
N_META = 16
GRID_W = 64
Q_BLOCK = 128
ROPE_THETA = 10000.0
NORM_EPS = 1e-6
MIX_WIDTH = D_MODEL
A_WIDTH = MIX_WIDTH // 2
A_Q_HEADS = A_WIDTH // HEAD_DIM
A_KV_HEADS = A_Q_HEADS // 4
A_GROUP = A_Q_HEADS // A_KV_HEADS
B_WIDTH = MIX_WIDTH - A_WIDTH
B_V_DIM = 2 * HEAD_DIM
B_HEADS = B_WIDTH // B_V_DIM
A_Q_COLS = A_Q_HEADS * HEAD_DIM
A_KV_COLS = A_KV_HEADS * HEAD_DIM
B_QK_COLS = B_HEADS * 2 * HEAD_DIM
B_V_COLS = B_HEADS * B_V_DIM
IN_COLS = A_Q_COLS + 2 * A_KV_COLS + 2 * B_QK_COLS + B_V_COLS
D_FF = ((8 * D_MODEL // 3 + 255) // 256) * 256
CONV_WIDTH = 3

kernel_name = "hymba_gqa_axial_diffattn_convglu_encoder"


def lambda_init_fn(layer):
    return 0.8 - 0.6 * math.exp(-0.3 * layer)


def rms_norm(x, g):
    x32 = x.astype(jnp.float32)
    y = x32 * lax.rsqrt(jnp.mean(x32 * x32, axis=-1, keepdims=True) + NORM_EPS)
    return (y * g.astype(jnp.float32)).astype(x.dtype)


def rope_rotate(x, angles):
    half = x.shape[-1] // 2
    x32 = x.astype(jnp.float32)
    x1, x2 = x32[..., :half], x32[..., half:]
    shape = (1, angles.shape[0]) + (1,) * (x.ndim - 3) + (half,)
    cos = jnp.cos(angles).reshape(shape)
    sin = jnp.sin(angles).reshape(shape)
    return jnp.concatenate([x1 * cos - x2 * sin, x2 * cos + x1 * sin], axis=-1).astype(x.dtype)


def axial_angles(n_tokens):
    n_rows = n_tokens // GRID_W
    t = jnp.arange(n_rows * GRID_W)
    row = (t // GRID_W).astype(jnp.float32)
    col = (t % GRID_W).astype(jnp.float32)
    axis_dim = HEAD_DIM // 2
    inv = ROPE_THETA ** (-jnp.arange(0, axis_dim, 2, dtype=jnp.float32) / axis_dim)
    ang = jnp.concatenate([row[:, None] * inv[None], col[:, None] * inv[None]], axis=-1)
    meta = jnp.zeros((N_META, HEAD_DIM // 2), jnp.float32)
    return jnp.concatenate([meta, ang], axis=0)


def linear_angles(n_total):
    pos = jnp.arange(n_total, dtype=jnp.float32)
    inv = ROPE_THETA ** (-jnp.arange(0, HEAD_DIM, 2, dtype=jnp.float32) / HEAD_DIM)
    return pos[:, None] * inv[None]


def sweep_query_blocks(q, block_fn):
    b, l = q.shape[0], q.shape[1]
    n_real = l - N_META
    nb = n_real // Q_BLOCK
    out_meta = block_fn(q[:, :N_META])
    qb = q[:, N_META:].reshape((b, nb, Q_BLOCK) + q.shape[2:])
    qb = jnp.moveaxis(qb, 1, 0)
    ob = lax.map(block_fn, qb)
    ob = jnp.moveaxis(ob, 0, 1).reshape((b, n_real) + ob.shape[3:])
    return jnp.concatenate([out_meta, ob], axis=1)


def mixer_sublayer(x, ang_a, ang_b, layer, g_mix, w_in, g_qnorm_a, g_knorm_a,
                   lambda_q1, lambda_k1, lambda_q2, lambda_k2, g_subln, w_out):
    b, l, _ = x.shape
    n = rms_norm(x, g_mix)
    proj = n @ w_in
    cuts = np.cumsum([A_Q_COLS, A_KV_COLS, A_KV_COLS, B_QK_COLS, B_QK_COLS]).tolist()
    qa, ka, va, qb, kb, vb = jnp.split(proj, cuts, axis=-1)
    scale = HEAD_DIM ** -0.5

    qa = qa.reshape(b, l, A_KV_HEADS, A_GROUP, HEAD_DIM)
    ka = ka.reshape(b, l, A_KV_HEADS, HEAD_DIM)
    va = va.reshape(b, l, A_KV_HEADS, HEAD_DIM)
    qa = rope_rotate(rms_norm(qa, g_qnorm_a), ang_a)
    ka = rope_rotate(rms_norm(ka, g_knorm_a), ang_a)

    def gqa_block(qblk):
        s = jnp.einsum('bqhgd,bkhd->bhgqk', qblk, ka, preferred_element_type=jnp.float32) * scale
        p = jax.nn.softmax(s, axis=-1).astype(va.dtype)
        return jnp.einsum('bhgqk,bkhd->bqhgd', p, va)

    oa = sweep_query_blocks(qa, gqa_block).reshape(b, l, A_WIDTH)

    qb = rope_rotate(qb.reshape(b, l, B_HEADS, 2, HEAD_DIM), ang_b)
    kb = rope_rotate(kb.reshape(b, l, B_HEADS, 2, HEAD_DIM), ang_b)
    vb = vb.reshape(b, l, B_HEADS, B_V_DIM)
    lam_init = lambda_init_fn(layer)
    lam = (jnp.exp(jnp.sum(lambda_q1.astype(jnp.float32) * lambda_k1.astype(jnp.float32)))
           - jnp.exp(jnp.sum(lambda_q2.astype(jnp.float32) * lambda_k2.astype(jnp.float32)))
           + lam_init)

    def diff_block(qblk):
        s = jnp.einsum('bqhcd,bkhcd->bhcqk', qblk, kb, preferred_element_type=jnp.float32) * scale
        p = jax.nn.softmax(s, axis=-1)
        a = (p[:, :, 0] - lam * p[:, :, 1]).astype(vb.dtype)
        return jnp.einsum('bhqk,bkhe->bqhe', a, vb)

    ob = sweep_query_blocks(qb, diff_block)
    ob = (rms_norm(ob, g_subln) * (1.0 - lam_init)).astype(x.dtype).reshape(b, l, B_WIDTH)

    mix = jnp.concatenate([oa, ob], axis=-1)
    return x + mix @ w_out


def conv_glu_sublayer(x, g_ffn, w_ff_gate, w_ff_up, conv_w, conv_b, w_ff_down):
    n = rms_norm(x, g_ffn)
    gate = n @ w_ff_gate
    pad = jnp.pad(gate, ((0, 0), (1, 1), (0, 0)))
    gate = pad[:, :-2] * conv_w[0] + pad[:, 1:-1] * conv_w[1] + pad[:, 2:] * conv_w[2] + conv_b
    return x + (jax.nn.gelu(gate, approximate=False) * (n @ w_ff_up)) @ w_ff_down


def trunk(x, meta_tokens, g_mix, w_in, g_qnorm_a, g_knorm_a, lambda_q1, lambda_k1,
          lambda_q2, lambda_k2, g_subln, w_out, g_ffn, w_ff_gate, w_ff_up, conv_w,
          conv_b, w_ff_down, g_final):
    b, s, d = x.shape
    meta = jnp.broadcast_to(meta_tokens[None].astype(x.dtype), (b, N_META, d))
    h = jnp.concatenate([meta, x], axis=1)
    ang_a = axial_angles(s)
    ang_b = linear_angles(s + N_META)
    for layer in range(DEPTH):
        h = mixer_sublayer(h, ang_a, ang_b, layer, g_mix[layer], w_in[layer],
                           g_qnorm_a[layer], g_knorm_a[layer], lambda_q1[layer],
                           lambda_k1[layer], lambda_q2[layer], lambda_k2[layer],
                           g_subln[layer], w_out[layer])
        h = conv_glu_sublayer(h, g_ffn[layer], w_ff_gate[layer], w_ff_up[layer],
                              conv_w[layer], conv_b[layer], w_ff_down[layer])
    h = rms_norm(h, g_final)
    return h[:, N_META:]


def setup_inputs(seed: int = 0) -> dict:
    key = jax.random.key(seed)
    ks = jax.random.split(key, 20)
    f32 = jnp.float32

    def nrm(k, shape, scale):
        return jax.random.normal(k, shape, f32) * scale

    def gain(k, shape):
        return 1.0 + 0.02 * jax.random.normal(k, shape, f32)

    return {
        "x_prompt": nrm(ks[0], (BATCH, SEQ, D_MODEL), 1.0),
        "x_sample": nrm(ks[1], (DEC_BATCH, DEC_SEQ, D_MODEL), 1.0),
        "meta_tokens": nrm(ks[2], (N_META, D_MODEL), 1.0),
        "g_mix": gain(ks[3], (DEPTH, D_MODEL)),
        "w_in": nrm(ks[4], (DEPTH, D_MODEL, IN_COLS), D_MODEL ** -0.5),
        "g_qnorm_a": gain(ks[5], (DEPTH, HEAD_DIM)),
        "g_knorm_a": gain(ks[6], (DEPTH, HEAD_DIM)),
        "lambda_q1": nrm(ks[7], (DEPTH, HEAD_DIM), 0.1),
        "lambda_k1": nrm(ks[8], (DEPTH, HEAD_DIM), 0.1),
        "lambda_q2": nrm(ks[9], (DEPTH, HEAD_DIM), 0.1),
        "lambda_k2": nrm(ks[10], (DEPTH, HEAD_DIM), 0.1),
        "g_subln": gain(ks[11], (DEPTH, B_V_DIM)),
        "w_out": nrm(ks[12], (DEPTH, MIX_WIDTH, D_MODEL), MIX_WIDTH ** -0.5),
        "g_ffn": gain(ks[13], (DEPTH, D_MODEL)),
        "w_ff_gate": nrm(ks[14], (DEPTH, D_MODEL, D_FF), D_MODEL ** -0.5),
        "w_ff_up": nrm(ks[15], (DEPTH, D_MODEL, D_FF), D_MODEL ** -0.5),
        "conv_w": nrm(ks[16], (DEPTH, CONV_WIDTH, D_FF), CONV_WIDTH ** -0.5),
        "conv_b": nrm(ks[17], (DEPTH, D_FF), 0.01),
        "w_ff_down": nrm(ks[18], (DEPTH, D_FF, D_MODEL), D_FF ** -0.5),
        "g_final": gain(ks[19], (D_MODEL,)),
    }


def reference(x_prompt, x_sample, meta_tokens, g_mix, w_in, g_qnorm_a, g_knorm_a,
              lambda_q1, lambda_k1, lambda_q2, lambda_k2, g_subln, w_out, g_ffn,
              w_ff_gate, w_ff_up, conv_w, conv_b, w_ff_down, g_final):
    y_prompt = trunk(x_prompt, meta_tokens, g_mix, w_in, g_qnorm_a, g_knorm_a,
                     lambda_q1, lambda_k1, lambda_q2, lambda_k2, g_subln, w_out,
                     g_ffn, w_ff_gate, w_ff_up, conv_w, conv_b, w_ff_down, g_final)
    y_sample = trunk(x_sample, meta_tokens, g_mix, w_in, g_qnorm_a, g_knorm_a,
                     lambda_q1, lambda_k1, lambda_q2, lambda_k2, g_subln, w_out,
                     g_ffn, w_ff_gate, w_ff_up, conv_w, conv_b, w_ff_down, g_final)
    return (y_prompt, y_sample)
```

```cpp
#include <hip/hip_runtime.h>
#include <hip/hip_bf16.h>
#include <hip/hip_cooperative_groups.h>
#include <cstdio>
#include <cstdint>
#include <cmath>
namespace cg = cooperative_groups;

constexpr int DM = 1024, FF = 2816, INC = 2304;
constexpr int NSEQ_P = 8, S_P = 4096, L_P = 4112, NSEQ_S = 32, S_S = 2048, L_S = 2064;
constexpr int ROWS_P = NSEQ_P * L_P;
constexpr int ROWS_S = NSEQ_S * L_S;
constexpr int MROWS = ROWS_P + ROWS_S;
constexpr int MPAD = 99072;
constexpr int OUT_ROWS_P = NSEQ_P * S_P;
constexpr int OUT_ROWS = OUT_ROWS_P + NSEQ_S * S_S;
constexpr float NORM_EPS = 1e-6f;
static_assert(MPAD % 256 == 0 && MPAD >= MROWS + 64, "pad");
static_assert(L_P % 64 == 16 && L_S % 64 == 16, "tail tile holds 16 keys");

struct RowInfo { int pos, L, xrow, grp, sidx; };
__device__ __forceinline__ RowInfo rowinfo(int row) {
    RowInfo r;
    if (row < ROWS_P) { const int s = row / L_P; r.pos = row - s * L_P; r.L = L_P; r.grp = 0; r.sidx = s; r.xrow = s * S_P + r.pos - 16; }
    else { const int q = row - ROWS_P; const int s = q / L_S; r.pos = q - s * L_S; r.L = L_S; r.grp = 1; r.sidx = NSEQ_P + s; r.xrow = s * S_S + r.pos - 16; }
    return r;
}
namespace pg8 {
#define PG8_LAS __attribute__((address_space(3)))
typedef unsigned short bf16_t;
typedef short bf16x8 __attribute__((ext_vector_type(8)));
typedef float f32x4 __attribute__((ext_vector_type(4)));
typedef unsigned u32x4 __attribute__((ext_vector_type(4)));
constexpr int BM = 256, BK = 64, HALF = 128, HTB = HALF * BK * 2  , STAGE_BYTES = 8 * HTB, NXCD = 8, WGM = 8;

__host__ __device__ __forceinline__ int lds_byte(int r, int c) { const int st = (r >> 4) * 2 + (c >> 5), rr = r & 15, cc = c & 31, ob = rr * 64 + cc * 2; return st * 1024 + (ob ^ (((ob >> 9) & 1) << 5)); }
__host__ __device__ __forceinline__ void stage_rc(int b, int& R, int& C) { const int st = b / 1024, sb = b % 1024, swz = sb ^ (((sb >> 9) & 1) << 5); R = (st >> 1) * 16 + swz / 64; C = (st & 1) * 32 + (swz % 64) / 2; }
__host__ __device__ __forceinline__ int perm32(int rho) { const int n = rho >> 4, i = rho & 15; return 8 * (i >> 2) + 4 * n + (i & 3); }

struct Unit { int pm, pn; };
struct Gemm { const bf16_t* A; const bf16_t* Bt; int M, N, K; };

struct StaticOrder {
    int nM, nN, nwg, G, c;
    __host__ __device__ void init(int M, int N, int G_, int c_) { nM = M / BM; nN = N / BM; nwg = nM * nN; G = G_; c = c_; }
    __host__ __device__ bool next(int i, Unit& u) const {
        const long L = (long)i * G + c; if (L >= nwg) return false;
        int wgid = (int)L; { const int q = nwg / NXCD, r = nwg % NXCD, xcd = wgid % NXCD, off = wgid / NXCD; wgid = (xcd < r ? xcd * (q + 1) : r * (q + 1) + (xcd - r) * q) + off; }
        const int nig = WGM * nN, gid = wgid / nig, fm = gid * WGM, gsz = (nM - fm) < WGM ? (nM - fm) : WGM;
        u.pm = fm + ((wgid % nig) % gsz); u.pn = (wgid % nig) / gsz; return true;
    }
    __device__ __forceinline__ void a_ready(const Unit&) const {}
    __device__ __forceinline__ void done(const Unit&) const {}
};

__device__ __forceinline__ unsigned cvt_pk_bf16(float lo, float hi) { unsigned r; asm volatile("v_cvt_pk_bf16_f32 %0, %1, %2" : "=v"(r) : "v"(lo), "v"(hi)); return r; }
typedef float f32x2 __attribute__((ext_vector_type(2)));
__device__ __forceinline__ f32x2 gelu_pk(f32x2 v) {
    const f32x2 av = __builtin_elementwise_abs(v), d = av * 0.2316418882f + 1.0f;
    f32x2 t; t.x = __builtin_amdgcn_rcpf(d.x); t.y = __builtin_amdgcn_rcpf(d.y);
    f32x2 q = t * 0.5307027145f + (-0.7265760135f); q = q * t + 0.7107068705f; q = q * t + (-0.142248368f); q = q * t + 0.127414796f; q = q * t;
    const f32x2 s = (v * v) * (-0.72134752044f);
    f32x2 e; e.x = __builtin_amdgcn_exp2f(s.x); e.y = __builtin_amdgcn_exp2f(s.y);
    const f32x2 m = v * (q * e), r = v - m;
    f32x2 o; o.x = v.x < 0.f ? m.x : r.x; o.y = v.y < 0.f ? m.y : r.y; return o;
}
__device__ __forceinline__ u32x4 pack8(const f32x4 a, const f32x4 b) { u32x4 w; w.x = cvt_pk_bf16(a[0], a[1]); w.y = cvt_pk_bf16(a[2], a[3]); w.z = cvt_pk_bf16(b[0], b[1]); w.w = cvt_pk_bf16(b[2], b[3]); return w; }
__device__ __forceinline__ float bflo(unsigned w) { return __uint_as_float(w << 16); }
__device__ __forceinline__ float bfhi(unsigned w) { return __uint_as_float(w & 0xffff0000u); }
__device__ __forceinline__ float dot4(const f32x4 a) { return (a[0] * a[0] + a[1] * a[1]) + (a[2] * a[2] + a[3] * a[3]); }

struct EpiQKV {
    static constexpr bool PERM = true, AFTER_DRAIN = false;
    bf16_t *QA, *KA, *VA, *QB, *KB, *VB; const float *cosA, *sinA, *cosB, *sinB, *gq, *gk; float* kmax2;
    __device__ __forceinline__ void operator()(const f32x4 (&acc)[2][2][4][2], const Unit& u, int wr, int wc, int fr, int fq) const {
        const int g = u.pn * 4 + wc;
        bf16_t* dst; int ldc, col; const float* gn = nullptr; const float* ct = nullptr; const float* st = nullptr;
        float qsc = 1.f; int kst = -1, kmul = 0;
        if (g < 8) { dst = QA; ldc = 512; col = 64 * g; gn = gq; ct = cosA; st = sinA; qsc = 0.125f * 1.4426950408889634f; }
        else if (g < 10) { dst = KA; ldc = 128; col = 64 * (g - 8); gn = gk; ct = cosA; st = sinA; kst = g - 8; kmul = 2; }
        else if (g < 12) { dst = VA; ldc = 128; col = 64 * (g - 10); }
        else if (g < 20) { dst = QB; ldc = 512; col = 64 * (g - 12); ct = cosB; st = sinB; qsc = 0.125f * 1.4426950408889634f; }
        else if (g < 28) { dst = KB; ldc = 512; col = 64 * (g - 20); ct = cosB; st = sinB; kst = 80 + (g - 20); kmul = 8; }
        else { dst = VB; ldc = 512; col = 64 * (g - 28); }
        f32x4 gv[2][2];
#pragma unroll
        for (int bj = 0; bj < 2; ++bj)
#pragma unroll
            for (int n = 0; n < 2; ++n) gv[bj][n] = gn ? *(const f32x4*)(gn + 32 * bj + 8 * fq + 4 * n) : (f32x4){1.f, 1.f, 1.f, 1.f};
#pragma unroll
        for (int ai = 0; ai < 2; ++ai)
#pragma unroll
            for (int m = 0; m < 4; ++m) {
                const int row = u.pm * BM + ai * HALF + wr * 64 + m * 16 + fr;
                f32x4 a0 = acc[ai][0][m][0], a1 = acc[ai][0][m][1], b0 = acc[ai][1][m][0], b1 = acc[ai][1][m][1];
                if (gn) {
                    float ss = (dot4(a0) + dot4(a1)) + (dot4(b0) + dot4(b1));
                    ss += __shfl_xor(ss, 16); ss += __shfl_xor(ss, 32);
                    const float r = rsqrtf(ss * (1.0f / 64.0f) + NORM_EPS);
                    a0 = a0 * r * gv[0][0]; a1 = a1 * r * gv[0][1]; b0 = b0 * r * gv[1][0]; b1 = b1 * r * gv[1][1];
                }
                if (ct) {
                    const RowInfo ri = rowinfo(row);
                    const float* cp = ct + ri.pos * 32 + 8 * fq; const float* sp = st + ri.pos * 32 + 8 * fq;
                    const f32x4 c0 = *(const f32x4*)cp, c1 = *(const f32x4*)(cp + 4), s0 = *(const f32x4*)sp, s1 = *(const f32x4*)(sp + 4);
                    const f32x4 y0 = a0 * c0 - b0 * s0, y1 = a1 * c1 - b1 * s1, z0 = b0 * c0 + a0 * s0, z1 = b1 * c1 + a1 * s1;
                    a0 = y0; a1 = y1; b0 = z0; b1 = z1;
                }
                a0 = a0 * qsc; a1 = a1 * qsc; b0 = b0 * qsc; b1 = b1 * qsc;
                if (kst >= 0) {
                    float kk = (dot4(a0) + dot4(a1)) + (dot4(b0) + dot4(b1));
                    kk += __shfl_xor(kk, 16); kk += __shfl_xor(kk, 32);
                    const RowInfo rk = rowinfo(row);
                    float* km = kmax2 + kst + kmul * rk.sidx;
                    if (fq == 0 && row < MROWS && kk > *km) atomicMax((unsigned*)km, __float_as_uint(kk));
                }
                bf16_t* p = dst + (size_t)row * ldc + col + 8 * fq;
                *(u32x4*)p = pack8(a0, a1); *(u32x4*)(p + 32) = pack8(b0, b1);
                asm volatile("" ::: "memory");
            }
    }
};

struct EpiWo {
    static constexpr bool PERM = true, AFTER_DRAIN = false;
    const float *xp, *xs, *meta; bf16_t* hb; float* rowss;
    __device__ __forceinline__ void operator()(const f32x4 (&acc)[2][2][4][2], const Unit& u, int wr, int wc, int fr, int fq) const {
        const int col0 = u.pn * BM + wc * 32 + 8 * fq;
#pragma unroll
        for (int ai = 0; ai < 2; ++ai)
#pragma unroll
            for (int m = 0; m < 4; ++m) {
                const int row = u.pm * BM + ai * HALF + wr * 64 + m * 16 + fr;
                const bool live = row < MROWS;
                const RowInfo ri = rowinfo(row);
                const float* hx = ri.grp ? xs : xp; asm volatile("" : "+v"(hx)); const float* hm = meta; asm volatile("" : "+v"(hm));
                const float* hp = ri.pos < 16 ? hm + (size_t)ri.pos * DM : hx + (size_t)ri.xrow * DM;
                float ss = 0.f;
#pragma unroll
                for (int bj = 0; bj < 2; ++bj) {
                    f32x4 v0 = acc[ai][bj][m][0], v1 = acc[ai][bj][m][1];
                    if (live) { v0 = v0 + *(const f32x4*)(hp + col0 + bj * HALF); v1 = v1 + *(const f32x4*)(hp + col0 + bj * HALF + 4); }
                    ss += dot4(v0) + dot4(v1);
                    *(u32x4*)(hb + (size_t)row * DM + col0 + bj * HALF) = pack8(v0, v1);
                }
                ss += __shfl_xor(ss, 16); ss += __shfl_xor(ss, 32);
                if (fq == 0 && live) atomicAdd(rowss + row, ss);
                asm volatile("" ::: "memory");
            }
    }
};

constexpr int GLO_LD = 1280, GHI_LD = 1536, GSPLIT = 5;
struct EpiGate {
    static constexpr bool PERM = true, AFTER_DRAIN = false;
    bf16_t *Glo, *Ghi; const float* rowss;
    __device__ __forceinline__ void operator()(const f32x4 (&acc)[2][2][4][2], const Unit& u, int wr, int wc, int fr, int fq) const {
        bf16_t* base; int ld, colt;
        if (u.pn < GSPLIT) { base = Glo; ld = GLO_LD; colt = u.pn * BM; } else { base = Ghi; ld = GHI_LD; colt = (u.pn - GSPLIT) * BM; }
        const int col0 = colt + wc * 32 + 8 * fq;
#pragma unroll
        for (int ai = 0; ai < 2; ++ai)
#pragma unroll
            for (int m = 0; m < 4; ++m) {
                const int row = u.pm * BM + ai * HALF + wr * 64 + m * 16 + fr;
                const float rs = rsqrtf(rowss[row] * (1.0f / DM) + NORM_EPS);
#pragma unroll
                for (int bj = 0; bj < 2; ++bj)
                    *(u32x4*)(base + (size_t)row * ld + col0 + bj * HALF) = pack8(acc[ai][bj][m][0] * rs, acc[ai][bj][m][1] * rs);
            }
    }
};

__device__ __forceinline__ void unpk8(const u32x4 g, f32x4& lo, f32x4& hi) {
    lo[0] = bflo(g.x); lo[1] = bfhi(g.x); lo[2] = bflo(g.y); lo[3] = bfhi(g.y); hi[0] = bflo(g.z); hi[1] = bfhi(g.z); hi[2] = bflo(g.w); hi[3] = bfhi(g.w);
}
struct EpiUp {
    static constexpr bool PERM = true, AFTER_DRAIN = false;
    const bf16_t *Glo, *Ghi; const float* rowss; const float *cw, *cb; bf16_t* act;
    __device__ __forceinline__ void operator()(const f32x4 (&acc)[2][2][4][2], const Unit& u, int wr, int wc, int fr, int fq) const {
        const bf16_t* base; int ld, colt;
        if (u.pn < GSPLIT) { base = Glo; ld = GLO_LD; colt = u.pn * BM; } else { base = Ghi; ld = GHI_LD; colt = (u.pn - GSPLIT) * BM; }
        const int gcol0 = colt + wc * 32 + 8 * fq, col0 = u.pn * BM + wc * 32 + 8 * fq;
#pragma unroll
        for (int ai = 0; ai < 2; ++ai)
#pragma unroll
            for (int m = 0; m < 4; ++m) {
                const int row = u.pm * BM + ai * HALF + wr * 64 + m * 16 + fr;
                const RowInfo ri = rowinfo(row);
                const bool hp = ri.pos > 0, hn = ri.pos < ri.L - 1;
                const float fp = hp ? 1.f : 0.f, fn = hn ? 1.f : 0.f;
                const float rs = rsqrtf(rowss[row] * (1.0f / DM) + NORM_EPS);
                const bf16_t* gp0 = base + (size_t)row * ld + gcol0;
                const int dm = hp ? -ld : 0, dx = hn ? ld : 0;
#pragma unroll
                for (int bj = 0; bj < 2; ++bj) {
                    const bf16_t* gp = gp0 + bj * HALF;
                    const u32x4 gc = *(const u32x4*)gp, gm = *(const u32x4*)(gp + dm), gx = *(const u32x4*)(gp + dx);
                    const float* wp = cw + col0 + bj * HALF;
                    f32x4 c0, c1, p0, p1, n0, n1; unpk8(gc, c0, c1); unpk8(gm, p0, p1); unpk8(gx, n0, n1);
                    f32x4 t0 = *(const f32x4*)(cb + col0 + bj * HALF) + *(const f32x4*)(wp + FF) * c0 + (*(const f32x4*)wp * p0) * fp + (*(const f32x4*)(wp + 2 * FF) * n0) * fn;
                    f32x4 t1 = *(const f32x4*)(cb + col0 + bj * HALF + 4) + *(const f32x4*)(wp + FF + 4) * c1 + (*(const f32x4*)(wp + 4) * p1) * fp + (*(const f32x4*)(wp + 2 * FF + 4) * n1) * fn;
                    const f32x2 ga = gelu_pk((f32x2){t0[0], t0[1]}), gb = gelu_pk((f32x2){t0[2], t0[3]}), gc2 = gelu_pk((f32x2){t1[0], t1[1]}), gd = gelu_pk((f32x2){t1[2], t1[3]});
                    const f32x4 u0 = acc[ai][bj][m][0] * rs, u1 = acc[ai][bj][m][1] * rs;
                    const f32x4 r0 = (f32x4){ga.x, ga.y, gb.x, gb.y} * u0, r1 = (f32x4){gc2.x, gc2.y, gd.x, gd.y} * u1;
                    *(u32x4*)(act + (size_t)row * FF + col0 + bj * HALF) = pack8(r0, r1);
                    asm volatile("" ::: "memory");
                }
            }
    }
};

struct EpiDown {
    static constexpr bool PERM = true, AFTER_DRAIN = false;
    const bf16_t* hb; float* out; float* rowss2;
    __device__ __forceinline__ void operator()(const f32x4 (&acc)[2][2][4][2], const Unit& u, int wr, int wc, int fr, int fq) const {
        const int col0 = u.pn * BM + wc * 32 + 8 * fq;
#pragma unroll
        for (int ai = 0; ai < 2; ++ai)
#pragma unroll
            for (int m = 0; m < 4; ++m) {
                const int row = u.pm * BM + ai * HALF + wr * 64 + m * 16 + fr;
                const RowInfo ri = rowinfo(row);
                const bool live = row < MROWS && ri.pos >= 16;
                const int orow = (ri.grp ? OUT_ROWS_P : 0) + ri.xrow;
                float ss = 0.f;
#pragma unroll
                for (int bj = 0; bj < 2; ++bj) {
                    if (live) {
                        const u32x4 h = *(const u32x4*)(hb + (size_t)row * DM + col0 + bj * HALF);
                        f32x4 v0 = acc[ai][bj][m][0], v1 = acc[ai][bj][m][1];
                        v0[0] += bflo(h.x); v0[1] += bfhi(h.x); v0[2] += bflo(h.y); v0[3] += bfhi(h.y); v1[0] += bflo(h.z); v1[1] += bfhi(h.z); v1[2] += bflo(h.w); v1[3] += bfhi(h.w);
                        ss += dot4(v0) + dot4(v1);
                        float* op = out + (size_t)orow * DM + col0 + bj * HALF;
                        *(f32x4*)op = v0; *(f32x4*)(op + 4) = v1;
                    }
                }
                ss += __shfl_xor(ss, 16); ss += __shfl_xor(ss, 32);
                if (fq == 0 && live) atomicAdd(rowss2 + orow, ss);
                asm volatile("" ::: "memory");
            }
    }
};
template <class Epi, class Sched, bool ALIGN_EPI = false, bool SP2 = false>
__device__ __forceinline__ void gemm_phase(PG8_LAS unsigned char* lds, const Gemm g, const Sched& S, const Epi& E) {
    int tid_ = threadIdx.x; asm volatile("" : "+v"(tid_));
    const int tid = tid_, wid = __builtin_amdgcn_readfirstlane(tid >> 6), lane = tid & 63, wr = wid >> 2, wc = wid & 3, fr = lane & 15, fq = lane >> 4;
    const int K = g.K, nt = K / BK;
    unsigned voffA[2], voffB[2];
#pragma unroll
    for (int i = 0; i < 2; ++i) { int R, C; stage_rc(tid * 16 + i * 8192, R, C); const int Rb = Epi::PERM ? ((R & ~31) + perm32(R & 31)) : R;
        voffA[i] = (unsigned)(R * K + C) * 2u; voffB[i] = (unsigned)(Rb * K + C) * 2u; }
    const size_t kstep = (size_t)(BK * 2);
    const size_t hstep = (size_t)HALF * K * 2;
    const size_t tstep = 2 * hstep;
    const unsigned ldsw = (unsigned)wid * 1024u;
    const int aoff = lds_byte(wr * 64 + fr, fq * 8), boff = lds_byte(wc * 32 + fr, fq * 8);
#define PG8_SA(b, h) (((b) * 2 + (h)) * HTB)
#define PG8_SB(b, h) ((4 + (b) * 2 + (h)) * HTB)
#define PG8_STAGE(bufoff, gbase, voff) do { _Pragma("unroll") for (int _i = 0; _i < 2; ++_i) \
        __builtin_amdgcn_global_load_lds((const unsigned*)((const char*)(gbase) + (voff)[_i]), (PG8_LAS unsigned*)(lds + (bufoff) + ldsw + _i * 8192), 16, 0, 0); } while (0)
#define PG8_LDA(dst, b, h) do { _Pragma("unroll") for (int m = 0; m < 4; ++m) _Pragma("unroll") for (int k = 0; k < 2; ++k) dst[m][k] = *(const PG8_LAS bf16x8*)(lds + PG8_SA(b, h) + aoff + m * 2048 + k * 1024); } while (0)
#define PG8_LDB(dst, b, h) do { _Pragma("unroll") for (int n = 0; n < 2; ++n) _Pragma("unroll") for (int k = 0; k < 2; ++k) dst[n][k] = *(const PG8_LAS bf16x8*)(lds + PG8_SB(b, h) + boff + n * 2048 + k * 1024); } while (0)
#define PG8_MMA(ai, bj, At, Bt) do { __builtin_amdgcn_s_setprio(1); _Pragma("unroll") for (int m = 0; m < 4; ++m) _Pragma("unroll") for (int n = 0; n < 2; ++n) _Pragma("unroll") for (int k = 0; k < 2; ++k) \
        acc[ai][bj][m][n] = __builtin_amdgcn_mfma_f32_16x16x32_bf16(Bt[n][k], At[m][k], acc[ai][bj][m][n], 0, 0, 0); __builtin_amdgcn_s_setprio(0); } while (0)
#define PG8_WAIT_V(n) asm volatile("s_waitcnt vmcnt(" #n ")" ::: "memory")
#define PG8_WAIT_L(n) asm volatile("s_waitcnt lgkmcnt(" #n ")" ::: "memory")
#define PG8_BAR __builtin_amdgcn_s_barrier()
#define PG8_SCHED __builtin_amdgcn_sched_barrier(0)
    Unit cur, nxt; int ui = 0;
    if (!S.next(0, cur)) return;
    f32x4 acc[2][2][4][2];
#pragma unroll
    for (int a = 0; a < 2; ++a)
#pragma unroll
        for (int b = 0; b < 2; ++b)
#pragma unroll
            for (int m = 0; m < 4; ++m)
#pragma unroll
                for (int n = 0; n < 2; ++n) acc[a][b][m][n] = (f32x4){0.f, 0.f, 0.f, 0.f};
    bf16x8 At[4][2], B0[2][2], B1[2][2];
    const char* cA = (const char*)g.A + (size_t)cur.pm * tstep; const char* cB = (const char*)g.Bt + (size_t)cur.pn * tstep;
    S.a_ready(cur);
    if constexpr (SP2) {
        PG8_STAGE(PG8_SB(0, 0), cB, voffB); PG8_STAGE(PG8_SB(0, 1), cB + hstep, voffB); PG8_STAGE(PG8_SA(0, 0), cA, voffA); PG8_STAGE(PG8_SA(0, 1), cA + hstep, voffA);
        if (wr == 1) PG8_BAR;
        PG8_WAIT_V(2); PG8_BAR;
        PG8_STAGE(PG8_SB(1, 0), cB + kstep, voffB); PG8_STAGE(PG8_SA(1, 0), cA + kstep, voffA); PG8_STAGE(PG8_SB(1, 1), cB + hstep + kstep, voffB);
        PG8_WAIT_V(6); PG8_BAR;
    } else {
        PG8_STAGE(PG8_SB(0, 0), cB, voffB); PG8_STAGE(PG8_SA(0, 0), cA, voffA); PG8_STAGE(PG8_SB(0, 1), cB + hstep, voffB); PG8_STAGE(PG8_SA(0, 1), cA + hstep, voffA);
        if (wr == 1) PG8_BAR;
        PG8_WAIT_V(4); PG8_BAR;
        PG8_STAGE(PG8_SB(1, 0), cB + kstep, voffB); PG8_STAGE(PG8_SA(1, 0), cA + kstep, voffA); PG8_STAGE(PG8_SB(1, 1), cB + hstep + kstep, voffB);
        PG8_WAIT_V(6); PG8_BAR;
    }
    for (;;) {
        const bool has_next = S.next(ui + 1, nxt);
        const char* nA = has_next ? (const char*)g.A + (size_t)nxt.pm * tstep : cA; const char* nB = has_next ? (const char*)g.Bt + (size_t)nxt.pn * tstep : cB;
        for (int t = 0; t < nt; t += 2) {
            const bool last = (t == nt - 2);
            const char* a1 = cA + (size_t)(t + 1) * kstep;
            const char* a2 = last ? nA : cA + (size_t)(t + 2) * kstep; const char* b2 = last ? nB : cB + (size_t)(t + 2) * kstep;
            const char* a3 = a2 + kstep; const char* b3 = b2 + kstep;
            if (last && has_next) S.a_ready(nxt);
            if constexpr (SP2) {
            PG8_LDB(B0, 0, 0); PG8_LDB(B1, 0, 1); PG8_SCHED; PG8_LDA(At, 0, 0); PG8_STAGE(PG8_SA(1, 1), a1 + hstep, voffA);
            PG8_WAIT_V(8); PG8_WAIT_L(0); PG8_BAR; PG8_MMA(0, 0, At, B0); PG8_MMA(0, 1, At, B1); PG8_BAR; PG8_SCHED;
            PG8_LDA(At, 0, 1); PG8_STAGE(PG8_SB(0, 0), b2, voffB); PG8_STAGE(PG8_SB(0, 1), b2 + hstep, voffB); PG8_STAGE(PG8_SA(0, 0), a2, voffA);
            PG8_WAIT_V(8); PG8_WAIT_L(0); PG8_BAR; PG8_MMA(1, 0, At, B0); PG8_MMA(1, 1, At, B1); PG8_BAR; PG8_SCHED;
            PG8_LDB(B0, 1, 0); PG8_LDB(B1, 1, 1); PG8_SCHED; PG8_LDA(At, 1, 0); PG8_STAGE(PG8_SA(0, 1), a2 + hstep, voffA);
            PG8_WAIT_V(8); PG8_WAIT_L(0); PG8_BAR; PG8_MMA(0, 0, At, B0); PG8_MMA(0, 1, At, B1); PG8_BAR; PG8_SCHED;
            PG8_LDA(At, 1, 1); PG8_STAGE(PG8_SB(1, 0), b3, voffB); PG8_STAGE(PG8_SB(1, 1), b3 + hstep, voffB); PG8_STAGE(PG8_SA(1, 0), a3, voffA);
            PG8_WAIT_V(8); PG8_WAIT_L(0); PG8_BAR; PG8_MMA(1, 0, At, B0); PG8_MMA(1, 1, At, B1); PG8_BAR; PG8_SCHED;
            } else {
            PG8_LDB(B0, 0, 0); PG8_SCHED; PG8_LDA(At, 0, 0); PG8_STAGE(PG8_SA(1, 1), a1 + hstep, voffA);
            PG8_WAIT_L(8); PG8_BAR; PG8_WAIT_L(0); PG8_MMA(0, 0, At, B0); PG8_BAR; PG8_SCHED;
            PG8_LDB(B1, 0, 1); PG8_STAGE(PG8_SB(0, 0), b2, voffB);
            PG8_BAR; PG8_WAIT_L(0); PG8_MMA(0, 1, At, B1); PG8_BAR;
            PG8_LDA(At, 0, 1); PG8_STAGE(PG8_SA(0, 0), a2, voffA);
            PG8_BAR; PG8_WAIT_L(0); PG8_MMA(1, 0, At, B0); PG8_BAR; PG8_SCHED;
            PG8_STAGE(PG8_SB(0, 1), b2 + hstep, voffB);
            PG8_WAIT_V(6); PG8_BAR; PG8_MMA(1, 1, At, B1); PG8_BAR;
            PG8_LDB(B0, 1, 0); PG8_SCHED; PG8_LDA(At, 1, 0); PG8_STAGE(PG8_SA(0, 1), a2 + hstep, voffA);
            PG8_WAIT_L(8); PG8_BAR; PG8_WAIT_L(0); PG8_MMA(0, 0, At, B0); PG8_BAR; PG8_SCHED;
            PG8_LDB(B1, 1, 1); PG8_STAGE(PG8_SB(1, 0), b3, voffB);
            PG8_BAR; PG8_WAIT_L(0); PG8_MMA(0, 1, At, B1); PG8_BAR;
            PG8_LDA(At, 1, 1); PG8_STAGE(PG8_SA(1, 0), a3, voffA);
            PG8_BAR; PG8_WAIT_L(0); PG8_MMA(1, 0, At, B0); PG8_BAR; PG8_SCHED;
            PG8_STAGE(PG8_SB(1, 1), b3 + hstep, voffB);
            PG8_WAIT_V(6); PG8_BAR; PG8_MMA(1, 1, At, B1); PG8_BAR;
            }
        }
        if constexpr (ALIGN_EPI) { if (wr == 0) PG8_BAR; }
        if constexpr (!Epi::AFTER_DRAIN) { E(acc, cur, wr, wc, fr, fq); S.done(cur); }
        if (!has_next) break;
#pragma unroll
        for (int a = 0; a < 2; ++a)
#pragma unroll
            for (int b = 0; b < 2; ++b)
#pragma unroll
                for (int m = 0; m < 4; ++m)
#pragma unroll
                    for (int n = 0; n < 2; ++n) acc[a][b][m][n] = (f32x4){0.f, 0.f, 0.f, 0.f};
        cur = nxt; cA = nA; cB = nB; ++ui;
        if constexpr (ALIGN_EPI) { if (wr == 1) PG8_BAR; }
    }
    PG8_WAIT_V(0);
    if constexpr (!ALIGN_EPI) { if (wr == 0) PG8_BAR; }
    PG8_BAR;
    if constexpr (Epi::AFTER_DRAIN) { E.fused(acc, cur, wr, wc, fr, fq, lds, wid, lane); S.done(cur); }
#undef PG8_SA
#undef PG8_SB
#undef PG8_STAGE
#undef PG8_LDA
#undef PG8_LDB
#undef PG8_MMA
#undef PG8_WAIT_V
#undef PG8_WAIT_L
#undef PG8_BAR
#undef PG8_SCHED
}
}
namespace ab {
using bf16=unsigned short;
using bf16x8=__attribute__((ext_vector_type(8)))short;
using s16x4=__attribute__((ext_vector_type(4)))short;
using f32x16=__attribute__((ext_vector_type(16)))float;
using u32x4=__attribute__((ext_vector_type(4)))unsigned;
constexpr int D=64, QP=512, KP=128, OP=1024;
constexpr int NW=8,QBLK=32,QB=QBLK*NW,KVBLK=64;
__device__ __forceinline__ int crow(int r,int hi){return (r&3)+8*(r>>2)+4*hi;}
#define SBAR() __builtin_amdgcn_sched_barrier(0)
__device__ __forceinline__ void cmask(f32x16&p0,f32x16&p1,int jb,int qrel,int hi){
  const float NEG=-INFINITY; (void)qrel; (void)hi;
  if(jb==2){
    #pragma unroll
    for(int r=8;r<16;++r)p0[r]=NEG;
    #pragma unroll
    for(int r=0;r<16;++r)p1[r]=NEG;
  } else if(jb==3){
    #pragma unroll
    for(int r=0;r<16;++r){p0[r]=NEG;p1[r]=NEG;}
  }
}

constexpr int NSLOT=3, SLOTB=8192;
constexpr int LDS_K=0, LDS_V=NSLOT*SLOTB, LDS_WS=2*NSLOT*SLOTB, LDS_OST=LDS_WS+NW*64*4, LDS_BYTES=LDS_OST+NW*4096;
constexpr float C2=0.125f*1.4426950408889634f;
__device__ __forceinline__ void glds16(const void*gsrc,unsigned lds_dst){unsigned keep;
  asm volatile("s_mov_b32 %0, m0\n\ts_mov_b32 m0, %2\n\ts_nop 0\n\tglobal_load_lds_dwordx4 %1, off\n\ts_mov_b32 m0, %0":"=&s"(keep):"v"(gsrc),"s"(lds_dst):"memory");}
__device__ __forceinline__ float max3f(float a,float b,float c){float r;asm("v_max3_f32 %0, %1, %2, %3":"=v"(r):"v"(a),"v"(b),"v"(c));return r;}
__device__ __forceinline__ float max2f(float a,float b){float r;asm("v_max_f32_e32 %0, %1, %2":"=v"(r):"v"(a),"v"(b));return r;}
__device__ __forceinline__ float fadd_s(float a,float b){float r;asm("v_add_f32_e32 %0, %1, %2":"=v"(r):"v"(a),"v"(b));return r;}
__device__ __forceinline__ float fsub_s(float a,float b){float r;asm("v_sub_f32_e32 %0, %1, %2":"=v"(r):"v"(a),"v"(b));return r;}
typedef float f32x2_t __attribute__((ext_vector_type(2))); typedef __bf16 bf16x2_t __attribute__((ext_vector_type(2)));
__device__ __forceinline__ unsigned cvtpk_s(float lo,float hi){f32x2_t v={lo,hi};bf16x2_t b=__builtin_convertvector(v,bf16x2_t);return __builtin_bit_cast(unsigned,b);}
#define WAIT_BAR(N) asm volatile("s_waitcnt vmcnt(" #N ") lgkmcnt(0)\n\ts_barrier":::"memory")

__device__ __forceinline__ void qkt(f32x16&p0,f32x16&p1,const char*Kslot,const bf16x8*qr,const f32x16&negm,int r32,int hi){
  const char*kb=Kslot+hi*1024+r32*16;
  #pragma unroll
  for(int d0=0;d0<4;++d0){
    const bf16x8 b0=*reinterpret_cast<const bf16x8*>(kb+d0*2048);
    const bf16x8 b1=*reinterpret_cast<const bf16x8*>(kb+d0*2048+512);
    if(d0==0){p0=__builtin_amdgcn_mfma_f32_32x32x16_bf16(b0,qr[0],negm,0,0,0);p1=__builtin_amdgcn_mfma_f32_32x32x16_bf16(b1,qr[0],negm,0,0,0);}
    else{p0=__builtin_amdgcn_mfma_f32_32x32x16_bf16(b0,qr[d0],p0,0,0,0);p1=__builtin_amdgcn_mfma_f32_32x32x16_bf16(b1,qr[d0],p1,0,0,0);}}
}
typedef __attribute__((address_space(3))) const char* lds_cptr;
typedef short v4i16_t __attribute__((ext_vector_type(4)));
__device__ __forceinline__ void kload8(bf16x8*kf,lds_cptr kp){
  kf[0]=*(const __attribute__((address_space(3))) bf16x8*)(kp);      kf[1]=*(const __attribute__((address_space(3))) bf16x8*)(kp+512);
  kf[2]=*(const __attribute__((address_space(3))) bf16x8*)(kp+2048); kf[3]=*(const __attribute__((address_space(3))) bf16x8*)(kp+2560);
  kf[4]=*(const __attribute__((address_space(3))) bf16x8*)(kp+4096); kf[5]=*(const __attribute__((address_space(3))) bf16x8*)(kp+4608);
  kf[6]=*(const __attribute__((address_space(3))) bf16x8*)(kp+6144); kf[7]=*(const __attribute__((address_space(3))) bf16x8*)(kp+6656);
}
__device__ __forceinline__ void kload2(bf16x8*kf,lds_cptr kp,int j){ kf[2*j]=*(const __attribute__((address_space(3))) bf16x8*)(kp+j*2048); kf[2*j+1]=*(const __attribute__((address_space(3))) bf16x8*)(kp+j*2048+512); }
__device__ __forceinline__ s16x4 vtr(lds_cptr p){ return __builtin_bit_cast(s16x4,__builtin_amdgcn_ds_read_tr16_b64_v4i16((__attribute__((address_space(3))) v4i16_t*)p)); }
__device__ __forceinline__ float rowmax(const f32x16&p0,const f32x16&p1){
  float a=max3f(p0[0],p0[1],p1[0]),b=max3f(p0[2],p0[3],p1[1]);a=max3f(a,p1[2],p1[3]);
  #pragma unroll
  for(int r=4;r<16;r+=4){a=max3f(a,p0[r],p0[r+1]);b=max3f(b,p0[r+2],p0[r+3]);a=max3f(a,p1[r],p1[r+1]);b=max3f(b,p1[r+2],p1[r+3]);}
  const float m=max2f(a,b);
  auto rr=__builtin_amdgcn_permlane32_swap(__float_as_uint(m),__float_as_uint(m),false,false);
  return max2f(__uint_as_float(rr[0]),__uint_as_float(rr[1]));
}
__device__ __forceinline__ void pv(f32x16*o,int vb,bf16x8 pa0,bf16x8 pa1,bf16x8 pa2,bf16x8 pa3){
  #pragma unroll
  for(int d0=0;d0<2;++d0){s16x4 lo[4],hi[4];
    #pragma unroll
    for(int ks=0;ks<4;++ks){
      asm volatile("ds_read_b64_tr_b16 %0,%1 offset:%c2":"=&v"(lo[ks]):"v"(vb),"i"(d0*4096+ks*1024):"memory");
      asm volatile("ds_read_b64_tr_b16 %0,%1 offset:%c2":"=&v"(hi[ks]):"v"(vb),"i"(d0*4096+ks*1024+512):"memory");}
    asm volatile("s_waitcnt lgkmcnt(0)":::"memory");SBAR();
    #define PK(k) (bf16x8){lo[k][0],lo[k][1],lo[k][2],lo[k][3],hi[k][0],hi[k][1],hi[k][2],hi[k][3]}
    o[d0]=__builtin_amdgcn_mfma_f32_32x32x16_bf16(pa0,PK(0),o[d0],0,0,0);
    o[d0]=__builtin_amdgcn_mfma_f32_32x32x16_bf16(pa1,PK(1),o[d0],0,0,0);
    o[d0]=__builtin_amdgcn_mfma_f32_32x32x16_bf16(pa2,PK(2),o[d0],0,0,0);
    o[d0]=__builtin_amdgcn_mfma_f32_32x32x16_bf16(pa3,PK(3),o[d0],0,0,0);
    #undef PK
  }
}

#ifndef ATTN_STORE16
#define ATTN_STORE16(p,v) (*(u32x4*)(p)=(v))
#endif
template<int THRL> __device__ __forceinline__ void attn_unit(const bf16*Qw0,const bf16*__restrict__ Kh,const bf16*__restrict__ Vh,bf16*Ow0,int NT,char*shm){
  int tid_=threadIdx.x; asm volatile("":"+v"(tid_));
  const int tid=tid_,lane=tid&63,r32=lane&31,hi=lane>>5; const int wid=__builtin_amdgcn_readfirstlane(tid>>6);
  const bf16*Qw=Qw0+(long)(wid*QBLK)*QP;
  const unsigned lds0=(unsigned)(uintptr_t)shm;
  float*wsf=(float*)(shm+LDS_WS)+wid*64;
  const bf16*ksrc=Kh+(long)lane*KP+wid*8;
  const bf16*vsrc=Vh+(long)(16*(wid&3)+(lane>>2))*KP+(wid>>2)*32+(lane&3)*8;
  const unsigned kdst=lds0+LDS_K+wid*1024, vdst=lds0+LDS_V+wid*1024;
  #define DMA_K(t,slot) glds16(ksrc+(long)(t)*KVBLK*KP,(unsigned)__builtin_amdgcn_readfirstlane(kdst+(slot)))
  #define DMA_V(t,slot) glds16(vsrc+(long)(t)*KVBLK*KP,(unsigned)__builtin_amdgcn_readfirstlane(vdst+(slot)))
  const int vb0=(int)(lds0+LDS_V)+((lane>>4)&1)*32+(lane&3)*8+(4*hi+((lane&15)>>2))*64;
  const char*Kbase=shm+LDS_K; bf16x8 kf[8];
  const lds_cptr shm3=(lds_cptr)shm; const lds_cptr kp0=shm3+LDS_K+hi*1024+r32*16; const lds_cptr vp0=shm3+LDS_V+((lane>>4)&1)*32+(lane&3)*8+(4*hi+((lane&15)>>2))*64;
  DMA_K(0,0);DMA_V(0,0);DMA_K(1,SLOTB);
  bf16x8 qr[4];
  #pragma unroll
  for(int d0=0;d0<4;++d0)qr[d0]=*reinterpret_cast<const bf16x8*>(&Qw[(long)r32*QP+d0*16+hi*8]);
  float mhat=0.f,l_reg=0.f;f32x16 o[2];o[0]=f32x16{};o[1]=f32x16{};f32x16 negm=f32x16{};asm volatile("":"+v"(negm));
  const int qrel=wid*QBLK+r32;
  #define CMASK(P0,P1,t) do{int jb_=(t)-(NT-4); if(jb_>=0)cmask(P0,P1,jb_,qrel,hi);}while(0)
  bool resc=false;
  #define START(P0,P1) do{ const float rm=rowmax(P0,P1); resc=false; \
    { const float dl=rm; mhat=fadd_s(mhat,dl); \
      _Pragma("unroll") for(int r=0;r<16;++r){P0[r]=fsub_s(P0[r],dl);P1[r]=fsub_s(P1[r],dl);} \
      _Pragma("unroll") for(int r=0;r<16;++r)negm[r]=-mhat; asm volatile("":"+v"(negm)); } \
    _Pragma("unroll") for(int r=0;r<16;++r)P0[r]=__builtin_amdgcn_exp2f(P0[r]); }while(0)
  #define RESC() do{ if(resc){ asm volatile("s_waitcnt lgkmcnt(0)":::"memory"); \
      _Pragma("unroll") for(int d_=0;d_<2;++d_) _Pragma("unroll") for(int r=0;r<16;++r)o[d_][r]*=wsf[crow(r,hi)]; } }while(0)
  f32x16 pA0,pA1,pB0,pB1;
  int sl_prev=0,sl_cur=0,sl_next=SLOTB;
  #define ROT() do{sl_prev=sl_cur;sl_cur=sl_next;sl_next=(sl_next==(NSLOT-1)*SLOTB)?0:sl_next+SLOTB;}while(0)
  DMA_K(2,2*SLOTB);
  WAIT_BAR(3);
  qkt(pA0,pA1,Kbase,qr,negm,r32,hi);asm volatile("s_nop 15\n\ts_nop 7":"+v"(pA0),"+v"(pA1));CMASK(pA0,pA1,0);
  START(pA0,pA1);
  _Pragma("unroll") for(int r=0;r<16;++r)pA1[r]=__builtin_amdgcn_exp2f(pA1[r]);
  WAIT_BAR(0);
  DMA_K(3,0);DMA_V(1,SLOTB);
  ROT();
  kload8(kf,kp0+sl_cur);
  WAIT_BAR(2);
  s16x4 vlo[8],vhi[8]; u32x4 pw0,pw1,pw2,pw3;
  #define PKW(P,B) cvtpk_s(P[B],P[B+1])
  #define PAF(k) __builtin_bit_cast(bf16x8,pw##k)
  #define VFR(i) (bf16x8){vlo[i][0],vlo[i][1],vlo[i][2],vlo[i][3],vhi[i][0],vhi[i][1],vhi[i][2],vhi[i][3]}
  #define PIN(x) asm volatile("":"+v"(x))
  #define MX3(a,b,c) __builtin_fmaxf(__builtin_fmaxf((a),(b)),(c))
  #define GAPA(MF,A0,A1,A2,A3,W0,W1,PW) do{ MF; sacc+=A0; sacc+=A1; sacc+=A2; sacc+=A3; PIN(sacc); W0; W1; PIN(PW); SBAR(); }while(0)
  #define EX(v) __builtin_amdgcn_exp2f(v)
  #define GAPB(MF,X,B) do{ MF; X[B]=EX(X[B]); X[B+1]=EX(X[B+1]); X[B+2]=EX(X[B+2]); X[B+3]=EX(X[B+3]); PIN(X); SBAR(); }while(0)
  #define VRD(i) do{ vlo[i]=vtr(vp_+(((i)>>2)*4096+((i)&3)*1024)); vhi[i]=vtr(vp_+(((i)>>2)*4096+((i)&3)*1024+512)); }while(0)
  #define KRD(G,j) do{ if(G){ kload2(kf,kp0+sl_next,j); SBAR(); } }while(0)
  #define STEP(C0,C1,P0,P1,t,GK,GV,GL) do{ SBAR(); \
    const lds_cptr vp_=vp0+sl_prev; \
    VRD(0); SBAR(); float sacc=(P0[0]+P0[1]); \
    GAPA(C0=__builtin_amdgcn_mfma_f32_32x32x16_bf16(kf[0],qr[0],negm,0,0,0), P0[2],P0[3],P0[4],P0[5],     pw0[0]=PKW(P0,0), pw0[1]=PKW(P0,2), pw0); \
    VRD(4); SBAR(); GAPA(C1=__builtin_amdgcn_mfma_f32_32x32x16_bf16(kf[1],qr[0],negm,0,0,0), P0[6],P0[7],P0[8],P0[9],     pw0[2]=PKW(P0,4), pw0[3]=PKW(P0,6), pw0); \
    VRD(1); SBAR(); GAPA(C0=__builtin_amdgcn_mfma_f32_32x32x16_bf16(kf[2],qr[1],C0,0,0,0),   P0[10],P0[11],P0[12],P0[13], pw1[0]=PKW(P0,8), pw1[1]=PKW(P0,10), pw1); \
    VRD(5); SBAR(); GAPA(C1=__builtin_amdgcn_mfma_f32_32x32x16_bf16(kf[3],qr[1],C1,0,0,0),   P0[14],P0[15],P1[0],P1[1],   pw1[2]=PKW(P0,12),pw1[3]=PKW(P0,14), pw1); \
    VRD(2); SBAR(); GAPA(C0=__builtin_amdgcn_mfma_f32_32x32x16_bf16(kf[4],qr[2],C0,0,0,0),   P1[2],P1[3],P1[4],P1[5],     pw2[0]=PKW(P1,0), pw2[1]=PKW(P1,2), pw2); \
    VRD(6); SBAR(); GAPA(C1=__builtin_amdgcn_mfma_f32_32x32x16_bf16(kf[5],qr[2],C1,0,0,0),   P1[6],P1[7],P1[8],P1[9],     pw2[2]=PKW(P1,4), pw2[3]=PKW(P1,6), pw2); \
    VRD(3); SBAR(); GAPA(C0=__builtin_amdgcn_mfma_f32_32x32x16_bf16(kf[6],qr[3],C0,0,0,0),   P1[10],P1[11],P1[12],P1[13], pw3[0]=PKW(P1,8), pw3[1]=PKW(P1,10), pw3); \
    VRD(7); SBAR(); GAPA(C1=__builtin_amdgcn_mfma_f32_32x32x16_bf16(kf[7],qr[3],C1,0,0,0),   P1[14],P1[15],0.f,0.f,       pw3[2]=PKW(P1,12),pw3[3]=PKW(P1,14), pw3); \
    l_reg+=sacc; \
    if(GK){DMA_K((t)+3,sl_cur);} if(GV){DMA_V((t)+1,sl_next);} \
    CMASK(C0,C1,t); \
    { float a=MX3(C0[0],C0[1],C1[0]),b=MX3(C0[2],C0[3],C1[1]); a=MX3(a,C1[2],C1[3]); \
      _Pragma("unroll") for(int r=4;r<16;r+=4){a=MX3(a,C0[r],C0[r+1]);b=MX3(b,C0[r+2],C0[r+3]);a=MX3(a,C1[r],C1[r+1]);b=MX3(b,C1[r+2],C1[r+3]);} \
      float rm=__builtin_fmaxf(a,b); { auto rr=__builtin_amdgcn_permlane32_swap(__float_as_uint(rm),__float_as_uint(rm),false,false); rm=__builtin_fmaxf(__uint_as_float(rr[0]),__uint_as_float(rr[1])); } \
      resc=false; \
      if(__builtin_expect(__any(rm>(float)THRL),0)){ const float dl=__builtin_fmaxf(rm,0.f); mhat+=dl; \
        _Pragma("unroll") for(int r=0;r<16;++r){C0[r]-=dl;C1[r]-=dl;} \
        _Pragma("unroll") for(int r=0;r<16;++r)negm[r]=-mhat; asm volatile("":"+v"(negm)); \
        const float f=__builtin_amdgcn_exp2f(-dl); l_reg*=f; if(hi==0)wsf[r32]=f; resc=true; } } \
    SBAR(); \
    GAPB(o[0]=__builtin_amdgcn_mfma_f32_32x32x16_bf16(PAF(0),VFR(0),o[0],0,0,0), C0,0); \
    GAPB(o[1]=__builtin_amdgcn_mfma_f32_32x32x16_bf16(PAF(0),VFR(4),o[1],0,0,0), C0,4); \
    KRD(GL,0); GAPB(o[0]=__builtin_amdgcn_mfma_f32_32x32x16_bf16(PAF(1),VFR(1),o[0],0,0,0), C0,8); \
    KRD(GL,1); GAPB(o[1]=__builtin_amdgcn_mfma_f32_32x32x16_bf16(PAF(1),VFR(5),o[1],0,0,0), C0,12); \
    KRD(GL,2); GAPB(o[0]=__builtin_amdgcn_mfma_f32_32x32x16_bf16(PAF(2),VFR(2),o[0],0,0,0), C1,0); \
    KRD(GL,3); GAPB(o[1]=__builtin_amdgcn_mfma_f32_32x32x16_bf16(PAF(2),VFR(6),o[1],0,0,0), C1,4); \
    GAPB(o[0]=__builtin_amdgcn_mfma_f32_32x32x16_bf16(PAF(3),VFR(3),o[0],0,0,0), C1,8); \
    GAPB(o[1]=__builtin_amdgcn_mfma_f32_32x32x16_bf16(PAF(3),VFR(7),o[1],0,0,0), C1,12); \
    }while(0)
  int t=1;
  #undef CMASK
  #define CMASK(P0,P1,t) do{}while(0)
  for(;t+5<NT;t+=2){
    STEP(pB0,pB1,pA0,pA1,t,true,true,true);     WAIT_BAR(2); RESC(); ROT();
    STEP(pA0,pA1,pB0,pB1,t+1,true,true,true);   WAIT_BAR(2); RESC(); ROT();
  }
  #undef CMASK
  #define CMASK(P0,P1,t) do{int jb_=(t)-(NT-4); if(jb_>=0)cmask(P0,P1,jb_,qrel,hi);}while(0)
  #define ENDW(tt) do{ if((tt)+3<NT){WAIT_BAR(2);} else if((tt)+2<NT){WAIT_BAR(1);} else {WAIT_BAR(0);} }while(0)
  for(;t+1<NT;t+=2){
    STEP(pB0,pB1,pA0,pA1,t,(t+3<NT),(t+1<NT),(t+1<NT));       ENDW(t);   RESC(); ROT();
    STEP(pA0,pA1,pB0,pB1,t+1,(t+4<NT),(t+2<NT),(t+2<NT));     ENDW(t+1); RESC(); ROT();
  }
  STEP(pB0,pB1,pA0,pA1,NT-1,false,false,false); RESC();
  { float sacc=pB0[0]+pB0[1]; _Pragma("unroll") for(int r=2;r<16;++r)sacc+=pB0[r]; _Pragma("unroll") for(int r=0;r<16;++r)sacc+=pB1[r]; l_reg+=sacc;
    pw0=(u32x4){PKW(pB0,0),PKW(pB0,2),PKW(pB0,4),PKW(pB0,6)};pw1=(u32x4){PKW(pB0,8),PKW(pB0,10),PKW(pB0,12),PKW(pB0,14)};pw2=(u32x4){PKW(pB1,0),PKW(pB1,2),PKW(pB1,4),PKW(pB1,6)};pw3=(u32x4){PKW(pB1,8),PKW(pB1,10),PKW(pB1,12),PKW(pB1,14)};
    SBAR(); pv(o,vb0+sl_cur,PAF(0),PAF(1),PAF(2),PAF(3)); }
  #undef PKW
  #undef PAF
  #undef VFR
  #undef PIN
  #undef MX3
  #undef GAPA
  #undef GAPB
  #undef EX
  #undef VRD
  #undef KRD
  #undef STEP
  #undef ENDW
  {auto rr=__builtin_amdgcn_permlane32_swap(__float_as_uint(l_reg),__float_as_uint(l_reg),false,false);l_reg=__uint_as_float(rr[0])+__uint_as_float(rr[1]);}
  if(hi==0)wsf[32+r32]=l_reg;asm volatile("s_waitcnt lgkmcnt(0)":::"memory");
  float rli[16];
  #pragma unroll
  for(int r=0;r<16;++r)rli[r]=__builtin_amdgcn_rcpf(wsf[32+crow(r,hi)]);
  bf16*Ow=Ow0+(long)(wid*QBLK)*OP;
  { bf16*stg=(bf16*)(shm+LDS_OST)+wid*2048;
    #pragma unroll
    for(int r=0;r<16;++r){const int orow=crow(r,hi);
      #pragma unroll
      for(int d0=0;d0<2;++d0)stg[orow*64+d0*32+r32]=(bf16)(cvtpk_s(o[d0][r]*rli[r],0.f)&0xffffu);}
    asm volatile("s_waitcnt lgkmcnt(0)":::"memory");
    #pragma unroll
    for(int i=0;i<4;++i){const int row=i*8+(lane>>3),ch=lane&7; const u32x4 v=*(const u32x4*)(stg+row*64+ch*8); ATTN_STORE16(Ow+(long)row*OP+ch*8,v);} }
  asm volatile("s_waitcnt lgkmcnt(0)\n\ts_barrier":::"memory");
  #undef DMA_K
  #undef DMA_V
  #undef CMASK
  #undef START
  #undef RESC
  #undef ROT
}
#undef SBAR
#undef WAIT_BAR
}
namespace att {
using bf16 = unsigned short;
using bf16x8 = __attribute__((ext_vector_type(8))) short;
using s16x4 = __attribute__((ext_vector_type(4))) short;
using f32x16 = __attribute__((ext_vector_type(16))) float;
using f32x4 = __attribute__((ext_vector_type(4))) float;
using u32x4 = __attribute__((ext_vector_type(4))) unsigned;
constexpr float SCALE = 0.125f, THR = 8.f;
#ifndef A_ONES
#define A_ONES 0
#endif
constexpr bool AONES = A_ONES;
constexpr int LDS_WS = 98304, LDS_STG = 0, STG_WAVE = 8704, LDS_UNIT = 147456 - 64;
#define SBAR() __builtin_amdgcn_sched_barrier(0)
__device__ __forceinline__ int crow(int r, int hi) { return (r & 3) + 8 * (r >> 2) + 4 * hi; }
__device__ __forceinline__ unsigned cvtpk(float lo, float hi) { unsigned r; asm volatile("v_cvt_pk_bf16_f32 %0, %1, %2" : "=v"(r) : "v"(lo), "v"(hi)); return r; }
template <int KW> __device__ __forceinline__ int kswz(int row, int cb) { if constexpr (KW == 64) return row * 128 + (cb ^ (((row >> 1) & 7) << 4)); else return row * 256 + (cb ^ ((row & 15) << 4)); }

template <bool SUB> __device__ __forceinline__ void partialSM(f32x16& p0, float nref) {
#pragma unroll
  for (int r = 0; r < 16; ++r) p0[r] = __builtin_amdgcn_exp2f(SUB ? p0[r] + nref : p0[r]);
}
template <bool SUB, bool SUM> __device__ __forceinline__ void finishSM(f32x16& p0, f32x16& p1, float nref, float& l_reg, bf16x8& pa0, bf16x8& pa1, bf16x8& pa2, bf16x8& pa3) {
#pragma unroll
  for (int r = 0; r < 16; ++r) p1[r] = __builtin_amdgcn_exp2f(SUB ? p1[r] + nref : p1[r]);
  if constexpr (SUM) {
    float ps = 0;
#pragma unroll
    for (int r = 0; r < 16; ++r) ps += p0[r];
#pragma unroll
    for (int r = 0; r < 16; ++r) ps += p1[r];
    l_reg += ps;
  }
#define PK4(P, BASE, OUT) do { unsigned a0 = cvtpk(P[BASE + 0], P[BASE + 1]), a1 = cvtpk(P[BASE + 2], P[BASE + 3]);   \
    unsigned b0 = cvtpk(P[BASE + 4], P[BASE + 5]), b1 = cvtpk(P[BASE + 6], P[BASE + 7]);                              \
    auto r0 = __builtin_amdgcn_permlane32_swap(a0, b0, false, false); auto r1 = __builtin_amdgcn_permlane32_swap(a1, b1, false, false); \
    u32x4 w = {r0[0], r1[0], r0[1], r1[1]}; OUT = *reinterpret_cast<bf16x8*>(&w); } while (0)
  PK4(p0, 0, pa0); PK4(p0, 8, pa1); PK4(p1, 0, pa2); PK4(p1, 8, pa3);
#undef PK4
}
template <int KW, bool CREF> __device__ __forceinline__ void qkt(f32x16& p0, f32x16& p1, const char* Ks, const bf16x8* qr, const f32x16& negm, int r32, int hi, int cboff) {
  if constexpr (!CREF) { p0 = f32x16{}; p1 = f32x16{}; }
#pragma unroll
  for (int d0 = 0; d0 < 4; ++d0) { const int cb = cboff + (d0 * 16 + hi * 8) * 2;
    const bf16x8 b0 = *reinterpret_cast<const bf16x8*>(Ks + kswz<KW>(r32, cb));
    const bf16x8 b1 = *reinterpret_cast<const bf16x8*>(Ks + kswz<KW>(32 + r32, cb));
    if (CREF && d0 == 0) { p0 = __builtin_amdgcn_mfma_f32_32x32x16_bf16(b0, qr[0], negm, 0, 0, 0); p1 = __builtin_amdgcn_mfma_f32_32x32x16_bf16(b1, qr[0], negm, 0, 0, 0); }
    else { p0 = __builtin_amdgcn_mfma_f32_32x32x16_bf16(b0, qr[d0], p0, 0, 0, 0); p1 = __builtin_amdgcn_mfma_f32_32x32x16_bf16(b1, qr[d0], p1, 0, 0, 0); } }
}
template <int NCB> __device__ __forceinline__ int v_st(int k, int c) { const int kk = (k & ~0xC) | ((k & 4) << 1) | ((k & 8) >> 1); return ((kk >> 3) * NCB + (c >> 5)) * 512 + ((kk & 7) * 32 + (c & 31)) * 2; }
__device__ __forceinline__ int v_rd_base(int lane) { return ((lane & 3) << 3) | (((lane >> 2) & 3) << 6) | (((lane >> 4) & 1) << 5) | (((lane >> 5) & 1) << 8); }
template <int NCB> constexpr int v_rd_off(int d0, int ks, int half) { return d0 * 512 + ks * (2 * NCB * 512) + half * (NCB * 512); }
template <int OFF> __device__ __forceinline__ s16x4 tr_read(int vb) { s16x4 r; asm volatile("ds_read_b64_tr_b16 %0, %1 offset:%2" : "=&v"(r) : "v"(vb), "i"(OFF) : "memory"); return r; }
template <int NCB, int D0> __device__ __forceinline__ void pv_one(f32x16& od, int vb, bf16x8 pa0, bf16x8 pa1, bf16x8 pa2, bf16x8 pa3) {
  const s16x4 l0 = tr_read<v_rd_off<NCB>(D0, 0, 0)>(vb), h0 = tr_read<v_rd_off<NCB>(D0, 0, 1)>(vb), l1 = tr_read<v_rd_off<NCB>(D0, 1, 0)>(vb), h1 = tr_read<v_rd_off<NCB>(D0, 1, 1)>(vb);
  const s16x4 l2 = tr_read<v_rd_off<NCB>(D0, 2, 0)>(vb), h2 = tr_read<v_rd_off<NCB>(D0, 2, 1)>(vb), l3 = tr_read<v_rd_off<NCB>(D0, 3, 0)>(vb), h3 = tr_read<v_rd_off<NCB>(D0, 3, 1)>(vb);
  asm volatile("s_waitcnt lgkmcnt(0)" ::: "memory"); SBAR();
#define PK(L, H) (bf16x8){L[0], L[1], L[2], L[3], H[0], H[1], H[2], H[3]}
  od = __builtin_amdgcn_mfma_f32_32x32x16_bf16(pa0, PK(l0, h0), od, 0, 0, 0);
  od = __builtin_amdgcn_mfma_f32_32x32x16_bf16(pa1, PK(l1, h1), od, 0, 0, 0);
  od = __builtin_amdgcn_mfma_f32_32x32x16_bf16(pa2, PK(l2, h2), od, 0, 0, 0);
  od = __builtin_amdgcn_mfma_f32_32x32x16_bf16(pa3, PK(l3, h3), od, 0, 0, 0);
#undef PK
}
struct HFrag { s16x4 l0, h0, l1, h1; };
template <int NCB, int HG> __device__ __forceinline__ void h_issue(HFrag& f, int vb) {
  constexpr int D0 = HG / 2, K0 = 2 * (HG % 2);
  f.l0 = tr_read<v_rd_off<NCB>(D0, K0, 0)>(vb); f.h0 = tr_read<v_rd_off<NCB>(D0, K0, 1)>(vb); f.l1 = tr_read<v_rd_off<NCB>(D0, K0 + 1, 0)>(vb); f.h1 = tr_read<v_rd_off<NCB>(D0, K0 + 1, 1)>(vb);
}
__device__ __forceinline__ void h_wait(HFrag& f) { asm volatile("s_waitcnt lgkmcnt(0)" : "+v"(f.l0), "+v"(f.h0), "+v"(f.l1), "+v"(f.h1) :: "memory"); }
__device__ __forceinline__ void h_mma(f32x16& od, const HFrag& f, bf16x8 paA, bf16x8 paB) {
#define PK(L, H) (bf16x8){L[0], L[1], L[2], L[3], H[0], H[1], H[2], H[3]}
  od = __builtin_amdgcn_mfma_f32_32x32x16_bf16(paA, PK(f.l0, f.h0), od, 0, 0, 0);
  od = __builtin_amdgcn_mfma_f32_32x32x16_bf16(paB, PK(f.l1, f.h1), od, 0, 0, 0);
#undef PK
}
template <int NCB> __device__ __forceinline__ void pv_all(f32x16* o, f32x16& lacc, int vb, bf16x8 pa0, bf16x8 pa1, bf16x8 pa2, bf16x8 pa3) {
  if constexpr (NCB == 4) {
    HFrag ha, hb;
    h_issue<NCB, 0>(ha, vb); h_wait(ha);
    h_issue<NCB, 1>(hb, vb); h_mma(o[0], ha, pa0, pa1); h_wait(hb);
    h_issue<NCB, 2>(ha, vb); h_mma(o[0], hb, pa2, pa3); h_wait(ha);
    h_issue<NCB, 3>(hb, vb); h_mma(o[1], ha, pa0, pa1); h_wait(hb);
    h_issue<NCB, 4>(ha, vb); h_mma(o[1], hb, pa2, pa3); h_wait(ha);
    h_issue<NCB, 5>(hb, vb); h_mma(o[2], ha, pa0, pa1); h_wait(hb);
    h_issue<NCB, 6>(ha, vb); h_mma(o[2], hb, pa2, pa3); h_wait(ha);
    h_issue<NCB, 7>(hb, vb); h_mma(o[3], ha, pa0, pa1); h_wait(hb);
    h_mma(o[3], hb, pa2, pa3);
    return;
  }
  pv_one<NCB, 0>(o[0], vb, pa0, pa1, pa2, pa3); pv_one<NCB, 1>(o[1], vb, pa0, pa1, pa2, pa3);
  if constexpr (NCB == 2 && AONES) {
    const bf16x8 ones = {0x3F80, 0x3F80, 0x3F80, 0x3F80, 0x3F80, 0x3F80, 0x3F80, 0x3F80};
    lacc = __builtin_amdgcn_mfma_f32_32x32x16_bf16(pa0, ones, lacc, 0, 0, 0); lacc = __builtin_amdgcn_mfma_f32_32x32x16_bf16(pa1, ones, lacc, 0, 0, 0);
    lacc = __builtin_amdgcn_mfma_f32_32x32x16_bf16(pa2, ones, lacc, 0, 0, 0); lacc = __builtin_amdgcn_mfma_f32_32x32x16_bf16(pa3, ones, lacc, 0, 0, 0);
  }
}

struct AttnArgs { const bf16 *QA, *KA, *VA, *QB, *KB, *VB; bf16* mix; const float* gsub; const float* kmax2; };

template <bool ISB> __device__ __forceinline__ void rowmap(int meta, int hidx, int qt, int wid, int i, int& pos, int& hq, bool& valid) {
  if constexpr (!ISB) {
    if (!meta) { pos = 16 + 256 * qt + 32 * wid + i; hq = hidx; valid = true; }
    else { pos = i & 15; hq = 4 * hidx + 2 * (wid & 1) + (i >> 4); valid = wid < 2; }
  } else {
    hq = hidx;
    if (!meta) { pos = 16 + 128 * qt + 32 * (wid >> 1) + i; valid = true; }
    else { pos = i & 15; valid = (wid < 2) && (i < 16); }
  }
}

template <bool ISB>
__device__ __forceinline__ void attn_unit(const AttnArgs& A, int seqbase, int sidx, int L, int hidx, int qt, int meta, char* lds, float lam) {
  constexpr int KW = ISB ? 128 : 64, DV = KW, LDK = ISB ? 512 : 128, NCB = DV / 32;
  constexpr int SHM_K = 64 * KW * 2, SHM_V = 64 * DV * 2;
  constexpr int NCH = KW / 8, RP = 512 / NCH, NP = 64 / RP;
  int tid_ = threadIdx.x; asm volatile("" : "+v"(tid_));
  const int tid = tid_, wid = tid >> 6, lane = tid & 63, r32 = lane & 31, hi = lane >> 5;
  char* V_lds = lds; char* K_lds = lds + 3 * SHM_V;
  float* ws = (float*)(lds + LDS_WS) + wid * 64; float* li_l = ws; float* al_l = ws + 32;
  const int comp = ISB ? (wid & 1) : 0, cboff = comp * 128;
  float l_reg = 0; f32x16 o[NCB]; bf16x8 qr[4]; f32x16 lacc = f32x16{};
#pragma unroll
  for (int d = 0; d < NCB; ++d) o[d] = f32x16{};
  { int pos, hq; bool valid; rowmap<ISB>(meta, hidx, qt, wid, r32, pos, hq, valid);
    const bf16* Qw = (ISB ? A.QB + (size_t)(seqbase + pos) * 512 + hq * 128 + comp * 64 : A.QA + (size_t)(seqbase + pos) * 512 + hq * 64) + hi * 8;
#pragma unroll
    for (int d0 = 0; d0 < 4; ++d0) qr[d0] = *reinterpret_cast<const bf16x8*>(Qw + d0 * 16); }
  const int kvh = ISB ? hidx : (meta ? hidx : (hidx >> 2));
  f32x16 negm; float mref;
  { float qs = 0.f;
#pragma unroll
    for (int d0 = 0; d0 < 4; ++d0)
#pragma unroll
      for (int e = 0; e < 8; ++e) { const float v = __uint_as_float(((unsigned)(unsigned short)qr[d0][e]) << 16); qs = fmaf(v, v, qs); }
    { auto rr = __builtin_amdgcn_permlane32_swap(__float_as_uint(qs), __float_as_uint(qs), false, false); qs = __uint_as_float(rr[0]) + __uint_as_float(rr[1]); }
    const float km2 = A.kmax2[ISB ? 80 + sidx * 8 + hidx * 2 + comp : sidx * 2 + kvh];
    mref = -(sqrtf(qs * km2) * 1.01f);
#pragma unroll
    for (int r = 0; r < 16; ++r) negm[r] = mref; }
  const bf16* Kh = (ISB ? A.KB + kvh * 128 : A.KA + kvh * 64) + (size_t)seqbase * LDK;
  const bf16* Vh = (ISB ? A.VB + kvh * 128 : A.VA + kvh * 64) + (size_t)seqbase * LDK;
  const int vb0 = (int)(uintptr_t)V_lds + v_rd_base(lane);
  const int NT = (L + 63) / 64;
  constexpr int NI = SHM_K / 8192;
  const int widu = __builtin_amdgcn_readfirstlane(wid);
  int kofs[NI], vofs[NI];
#pragma unroll
  for (int i = 0; i < NI; ++i) { const int o = (widu * NI + i) * 1024 + lane * 16;
    if constexpr (KW == 128) { const int row = o >> 8, lg = ((o >> 4) & 15) ^ (row & 15); kofs[i] = row * LDK + lg * 8; }
    else { const int row = o >> 7, lg = ((o >> 4) & 7) ^ ((row >> 1) & 7); kofs[i] = row * LDK + lg * 8; }
    { const int sb = o >> 9, g = sb / NCB, cb = sb % NCB, rr = (o >> 6) & 7, cc = (o & 63) >> 1, kk = g * 8 + rr, k = (kk & ~0xC) | ((kk & 4) << 1) | ((kk & 8) >> 1); vofs[i] = k * LDK + cb * 32 + cc; } }
  typedef __attribute__((address_space(3))) unsigned lds_u32;
#define DMA(t, slot) do { const int tt_ = (t) < NT ? (t) : NT - 1; _Pragma("unroll") for (int i_ = 0; i_ < NI; ++i_) { \
    __builtin_amdgcn_global_load_lds((const unsigned*)(Kh + (size_t)tt_ * 64 * LDK + kofs[i_]), (lds_u32*)(K_lds + (slot) * SHM_K + (widu * NI + i_) * 1024), 16, 0, 0); \
    __builtin_amdgcn_global_load_lds((const unsigned*)(Vh + (size_t)tt_ * 64 * LDK + vofs[i_]), (lds_u32*)(V_lds + (slot) * SHM_V + (widu * NI + i_) * 1024), 16, 0, 0); } } while (0)
  f32x16 pA0 = f32x16{}, pA1 = f32x16{}, pB0 = f32x16{}, pB1 = f32x16{}; bf16x8 pa0 = bf16x8{}, pa1 = bf16x8{}, pa2 = bf16x8{}, pa3 = bf16x8{};
  const bool wact = !meta || widu < 2;
  DMA(0, 0); DMA(1, 1); DMA(2, 2);
  asm volatile("s_waitcnt vmcnt(0)" ::: "memory"); __syncthreads();
  if (wact) { qkt<KW, true>(pA0, pA1, K_lds, qr, negm, r32, hi, cboff); partialSM<false>(pA0, mref); }
  int bprev = 0, bcur = 1, bnext = 2;
#define HALFSTEP(X0, X1, Y0, Y1, LAST) do { \
    SBAR(); if (wact) { qkt<KW, true>(X0, X1, K_lds + bcur * SHM_K, qr, negm, r32, hi, cboff); \
    if (LAST) { asm volatile("" ::: "memory"); _Pragma("unroll") for (int r = 8; r < 16; ++r) X0[r] = -1e30f; _Pragma("unroll") for (int r = 0; r < 16; ++r) X1[r] = -1e30f; } \
    finishSM<false, ISB || !AONES>(Y0, Y1, mref, l_reg, pa0, pa1, pa2, pa3); } SBAR(); \
    if (wact) { pv_all<NCB>(o, lacc, vb0 + bprev * SHM_V, pa0, pa1, pa2, pa3); partialSM<false>(X0, mref); } \
    asm volatile("s_waitcnt vmcnt(0)" ::: "memory"); __syncthreads(); DMA(t + 2, bprev); \
    { const int t_ = bprev; bprev = bcur; bcur = bnext; bnext = t_; } } while (0)
  for (int t = 1; t < NT; t += 2) {
    { HALFSTEP(pB0, pB1, pA0, pA1, false); }
    { const int t0_ = t; const int t = t0_ + 1; HALFSTEP(pA0, pA1, pB0, pB1, __builtin_expect(t + 1 == NT, 0)); }
  }
  if (wact) { finishSM<false, ISB || !AONES>(pA0, pA1, mref, l_reg, pa0, pa1, pa2, pa3); SBAR();
  pv_all<NCB>(o, lacc, vb0 + bprev * SHM_V, pa0, pa1, pa2, pa3); }
  asm volatile("s_waitcnt vmcnt(0)" ::: "memory"); __syncthreads();
  float rli[16];
  if constexpr (ISB || !AONES) {
    { auto rr = __builtin_amdgcn_permlane32_swap(__float_as_uint(l_reg), __float_as_uint(l_reg), false, false); l_reg = __uint_as_float(rr[0]) + __uint_as_float(rr[1]); }
    if (hi == 0) li_l[r32] = l_reg; asm volatile("s_waitcnt lgkmcnt(0)" ::: "memory");
#pragma unroll
    for (int r = 0; r < 16; ++r) rli[r] = __builtin_amdgcn_rcpf(li_l[crow(r, hi)]);
  } else {
#pragma unroll
    for (int r = 0; r < 16; ++r) rli[r] = __builtin_amdgcn_rcpf(lacc[r]);
  }
  const int i2 = lane >> 1, half = lane & 1;
  int pos2, hq2; bool valid2; rowmap<ISB>(meta, hidx, qt, wid, i2, pos2, hq2, valid2);
  if constexpr (!ISB) {
    float* stg = (float*)(lds + LDS_STG + wid * STG_WAVE);
#pragma unroll
    for (int r = 0; r < 16; ++r)
#pragma unroll
      for (int d0 = 0; d0 < 2; ++d0) stg[crow(r, hi) * 68 + d0 * 32 + r32] = o[d0][r] * rli[r];
    asm volatile("s_waitcnt lgkmcnt(0)" ::: "memory");
    bf16* Op = A.mix + (size_t)(seqbase + pos2) * 1024 + hq2 * 64 + half * 32;
#pragma unroll
    for (int c = 0; c < 4; ++c) { const f32x4 a = *(const f32x4*)(stg + i2 * 68 + half * 32 + c * 8), b = *(const f32x4*)(stg + i2 * 68 + half * 32 + c * 8 + 4);
      u32x4 w = {cvtpk(a[0], a[1]), cvtpk(a[2], a[3]), cvtpk(b[0], b[1]), cvtpk(b[2], b[3])}; if (valid2) *(u32x4*)(Op + c * 8) = w; }
  } else {
    float* reg = (float*)(lds + LDS_STG + (wid & ~1) * STG_WAVE);
#pragma unroll
    for (int d = 0; d < 4; ++d)
#pragma unroll
      for (int r = 0; r < 16; ++r) o[d][r] *= rli[r];
    if (comp == 1) {
#pragma unroll
      for (int d = 0; d < 4; ++d)
#pragma unroll
        for (int r = 0; r < 16; ++r) reg[(d * 16 + r) * 64 + lane] = o[d][r];
    }
    __syncthreads();
    if (comp == 0) {
#pragma unroll
      for (int d = 0; d < 4; ++d)
#pragma unroll
        for (int r = 0; r < 16; ++r) o[d][r] -= lam * reg[(d * 16 + r) * 64 + lane];
      asm volatile("s_waitcnt lgkmcnt(0)" ::: "memory");
#pragma unroll
      for (int d = 0; d < 4; ++d)
#pragma unroll
        for (int r = 0; r < 16; ++r) reg[crow(r, hi) * 132 + d * 32 + r32] = o[d][r];
      asm volatile("s_waitcnt lgkmcnt(0)" ::: "memory");
      f32x4 v[16]; float ss = 0.f;
#pragma unroll
      for (int c = 0; c < 16; ++c) { v[c] = *(const f32x4*)(reg + i2 * 132 + half * 64 + c * 4); ss += (v[c][0] * v[c][0] + v[c][1] * v[c][1]) + (v[c][2] * v[c][2] + v[c][3] * v[c][3]); }
      ss += __shfl_xor(ss, 1);
      const float rs = rsqrtf(ss * (1.0f / 128.0f) + NORM_EPS) * 0.8f;
      bf16* Op = A.mix + (size_t)(seqbase + pos2) * 1024 + 512 + hq2 * 128 + half * 64;
      const float* gp = A.gsub + half * 64;
#pragma unroll
      for (int c = 0; c < 8; ++c) { const f32x4 g0 = *(const f32x4*)(gp + c * 8), g1 = *(const f32x4*)(gp + c * 8 + 4); const f32x4 a = v[2 * c] * g0 * rs, b = v[2 * c + 1] * g1 * rs;
        u32x4 w = {cvtpk(a[0], a[1]), cvtpk(a[2], a[3]), cvtpk(b[0], b[1]), cvtpk(b[2], b[3])}; if (valid2) *(u32x4*)(Op + c * 8) = w; }
    }
  }
#undef DMA
#undef HALFSTEP
}
#undef SBAR

constexpr int U1 = 32, U2 = 16, U3 = 1024, U4 = 1024, U5 = 128, U6 = 64, U7 = 2048, U8 = 2048, NUNITS = U1 + U2 + U3 + U4 + U5 + U6 + U7 + U8;
__device__ __forceinline__ void attn_phase(const AttnArgs& A, char* lds, unsigned* counter, float lam) {
  volatile int* s_unit = (volatile int*)(lds + LDS_UNIT);
  for (;;) {
    __syncthreads();
    if (threadIdx.x == 0) *s_unit = (int)atomicAdd(counter, 1u);
    __syncthreads();
    int u = *s_unit;
    if (u >= NUNITS) break;
    int isB, meta, grp, seq, h, qt = 0;
    if (u < U1) { isB = 1; meta = 1; grp = 0; seq = u >> 2; h = u & 3; }
    else if ((u -= U1) < U2) { isB = 0; meta = 1; grp = 0; seq = u >> 1; h = u & 1; }
    else if ((u -= U2) < U3) { isB = 1; meta = 0; grp = 0; seq = u >> 7; h = (u & 127) >> 5; qt = u & 31; }
    else if ((u -= U3) < U4) { isB = 0; meta = 0; grp = 0; seq = u >> 7; h = (u & 127) >> 4; qt = u & 15; }
    else if ((u -= U4) < U5) { isB = 1; meta = 1; grp = 1; seq = u >> 2; h = u & 3; }
    else if ((u -= U5) < U6) { isB = 0; meta = 1; grp = 1; seq = u >> 1; h = u & 1; }
    else if ((u -= U6) < U7) { isB = 1; meta = 0; grp = 1; seq = u >> 6; h = (u & 63) >> 4; qt = u & 15; }
    else { u -= U7; isB = 0; meta = 0; grp = 1; seq = u >> 6; h = (u & 63) >> 3; qt = u & 7; }
    const int seqbase = grp ? ROWS_P + seq * L_S : seq * L_P, L = grp ? L_S : L_P;
    const int sidx = grp ? NSEQ_P + seq : seq;
#if !defined(ONLY_A)
    if (isB) attn_unit<true>(A, seqbase, sidx, L, h, qt, meta, lds, lam);
#endif
#if !defined(ONLY_B)
    if (!isB) {
      if (!meta) {
        const size_t qrow = (size_t)(seqbase + 16 + 256 * qt);
        ab::attn_unit<8>(A.QA + qrow * 512 + h * 64, A.KA + (size_t)seqbase * 128 + (h >> 2) * 64, A.VA + (size_t)seqbase * 128 + (h >> 2) * 64, A.mix + qrow * 1024 + h * 64, (L + 127) / 128 * 2, lds);
      } else attn_unit<false>(A, seqbase, sidx, L, h, qt, meta, lds, lam);
    }
#endif
  }
}
}
constexpr size_t WS_CTL = 0;
constexpr size_t WS_RSS1 = 4096, WS_RSS2 = WS_RSS1 + (size_t)MPAD * 4;
constexpr size_t WS_TAB = 1u << 20;
constexpr size_t TAB_BYTES = (size_t)L_P * 32 * 4;
constexpr size_t WS_W = 4u << 20;
constexpr size_t WS_WIN = WS_W, WS_WO = WS_WIN + (size_t)INC * DM * 2, WS_WG = WS_WO + (size_t)DM * DM * 2, WS_WU = WS_WG + (size_t)FF * DM * 2, WS_WD = WS_WU + (size_t)FF * DM * 2;
constexpr size_t WS_BIG = 28u << 20;
static_assert(WS_WD + (size_t)FF * DM * 2 <= WS_BIG && WS_RSS2 + (size_t)MPAD * 4 <= WS_TAB && WS_TAB + 4 * TAB_BYTES <= WS_W, "ws map");
constexpr size_t WS_HB = WS_BIG;
constexpr size_t WS_ACT = WS_HB + (size_t)MPAD * DM * 2;
constexpr size_t WS_GLO = WS_ACT + (size_t)MPAD * FF * 2;
constexpr size_t WS_END = WS_GLO + (size_t)MPAD * 1280 * 2 + 65536;
constexpr size_t WS_XN = WS_ACT;
constexpr size_t WS_QA = WS_XN + (size_t)MPAD * DM * 2, WS_KA = WS_QA + (size_t)MPAD * 512 * 2, WS_VA = WS_KA + (size_t)MPAD * 128 * 2,
                 WS_QB = WS_VA + (size_t)MPAD * 128 * 2, WS_KB = WS_QB + (size_t)MPAD * 512 * 2, WS_VB = WS_KB + (size_t)MPAD * 512 * 2;
static_assert(WS_VB + (size_t)MPAD * 512 * 2 <= WS_END, "ws map 2");
static_assert((size_t)MPAD * 1536 * 2 <= (size_t)OUT_ROWS * DM * 4, "Ghi fits in d_out");
constexpr int LDS_BYTES = 147456;

#define LAS __attribute__((address_space(3)))
typedef unsigned short bf16;
typedef float f32x4 __attribute__((ext_vector_type(4)));
typedef unsigned v4u __attribute__((ext_vector_type(4)));
typedef unsigned v2u __attribute__((ext_vector_type(2)));
__device__ __forceinline__ unsigned pk2(float lo, float hi) { return pg8::cvt_pk_bf16(lo, hi); }
__device__ __forceinline__ float wave_sum(float v) {
#pragma unroll
    for (int o = 1; o < 64; o <<= 1) v += __shfl_xor(v, o);
    return v;
}
__device__ const double INVB[32] = {1.0, 0.7498942093324559, 0.5623413251903491, 0.4216965034285822, 0.31622776601683794, 0.23713737056616552, 0.1778279410038923, 0.1333521432163324,
    0.1, 0.07498942093324558, 0.05623413251903491, 0.042169650342858224, 0.03162277660168379, 0.023713737056616554, 0.01778279410038923, 0.01333521432163324,
    0.01, 0.007498942093324558, 0.005623413251903491, 0.004216965034285823, 0.0031622776601683794, 0.0023713737056616554, 0.0017782794100389228, 0.001333521432163324,
    0.001, 0.0007498942093324559, 0.0005623413251903491, 0.00042169650342858224, 0.00031622776601683794, 0.00023713737056616554, 0.00017782794100389227, 0.0001333521432163324};
__device__ __forceinline__ void sincos_d(double x, float& s, float& c) {
    const double k = rint(x * 0.6366197723675814);
    double r = fma(-k, 1.5707963267948966, x); r = fma(-k, 6.123233995736766e-17, r);
    const int q = ((int)k) & 3; const double r2 = r * r;
    const double sp = r * (1.0 + r2 * (-1.0 / 6 + r2 * (1.0 / 120 + r2 * (-1.0 / 5040 + r2 * (1.0 / 362880 + r2 * (-1.0 / 39916800 + r2 * (1.0 / 6227020800.0)))))));
    const double cp = 1.0 + r2 * (-0.5 + r2 * (1.0 / 24 + r2 * (-1.0 / 720 + r2 * (1.0 / 40320 + r2 * (-1.0 / 3628800 + r2 * (1.0 / 479001600 + r2 * (-1.0 / 87178291200.0)))))));
    const double ss = (q & 1) ? cp : sp, cc = (q & 1) ? sp : cp;
    s = (float)((q & 2) ? -ss : ss); c = (float)(((q + 1) & 2) ? -cc : cc);
}
__device__ __forceinline__ void transpose_item(const float* W, int K, int N, bf16* WT, const float* gs, bool perm, LAS float* scr, int item, int lane) {
    const int nblk = N / 32, kb = item / nblk, nb = item % nblk, k0 = 64 * kb, n0 = 32 * nb;
#pragma unroll 8
    for (int i = 0; i < 32; ++i) { const int kk = 2 * i + (lane >> 5); float v = W[(size_t)(k0 + kk) * N + n0 + (lane & 31)]; if (gs) v *= gs[k0 + kk]; scr[kk * 33 + (lane & 31)] = v; }
    asm volatile("s_waitcnt lgkmcnt(0)" ::: "memory");
    const int c = lane & 7;
    const int t0 = perm ? ((n0 >> 8) * 256 + ((n0 >> 5) & 1) * 128 + ((n0 >> 6) & 3) * 32) : n0;
#pragma unroll
    for (int j = 0; j < 4; ++j) { const int n = (lane >> 3) + 8 * j; const LAS float* s = scr + (8 * c) * 33 + n;
        v4u o; o.x = pk2(s[0 * 33], s[1 * 33]); o.y = pk2(s[2 * 33], s[3 * 33]); o.z = pk2(s[4 * 33], s[5 * 33]); o.w = pk2(s[6 * 33], s[7 * 33]);
        *(v4u*)(WT + (size_t)(t0 + n) * K + k0 + 8 * c) = o; }
    asm volatile("s_waitcnt lgkmcnt(0)" ::: "memory");
}

#define XB_TMO      128
#define XB_XCNT(j)  (256  + 64 * (j))
#define XB_XSUB(j)  (1280 + 64 * (j))
#define XB_XGEN(j)  (2304 + 64 * (j))
#define XB_TOP      3328
#define XB_TOPGEN   3392
#define XCD_BAR_WORDS 3456
#define XB_SPIN_CAP (1u << 18)

__device__ __forceinline__ unsigned xb_ld(unsigned* p)              { return __hip_atomic_load(p, __ATOMIC_RELAXED, __HIP_MEMORY_SCOPE_AGENT); }
__device__ __forceinline__ unsigned xb_add(unsigned* p, unsigned v) { return __hip_atomic_fetch_add(p, v, __ATOMIC_RELAXED, __HIP_MEMORY_SCOPE_AGENT); }
__device__ __forceinline__ unsigned xb_xcc_id() { return (unsigned)__builtin_amdgcn_s_getreg((3 << 11) | 20) & 0xFu; }
#define XB_SPIN(cond, bar) do { unsigned _sp = 0; while (cond) { __builtin_amdgcn_s_sleep(1); \
    if ((++_sp & 255u) == 0u) { if (xb_ld(&(bar)[XB_TMO])) break; if (_sp > XB_SPIN_CAP) { atomicAdd(&(bar)[XB_TMO], 1u); break; } } } } while (0)

struct XcdBarrier {
    unsigned* bar; unsigned x;
    volatile LAS unsigned* st;
};

__device__ __forceinline__ XcdBarrier xcd_barrier_post(unsigned* bar, volatile LAS unsigned* st) {
    XcdBarrier b; b.bar = bar; b.x = xb_xcc_id(); b.st = st;
    if (threadIdx.x == 0) (void)xb_add(&bar[XB_XCNT(b.x)], 1u);
    return b;
}
__device__ __forceinline__ void xcd_barrier_complete(unsigned* bar, unsigned x, unsigned& nloc, unsigned& nx) {
    const unsigned G = gridDim.x * gridDim.y * gridDim.z;
    unsigned sum, cnt, mine, sp = 0u;
    for (;;) {
        sum = 0u; cnt = 0u; mine = 0u;
#pragma unroll
        for (unsigned j = 0; j < 16; ++j) { const unsigned c = xb_ld(&bar[XB_XCNT(j)]); sum += c; cnt += (c > 0u) ? 1u : 0u; mine = (j == x) ? c : mine; }
        if (sum == G) break;
        __builtin_amdgcn_s_sleep(1);
        if ((++sp & 255u) == 0u) { if (xb_ld(&bar[XB_TMO])) break; if (sp > XB_SPIN_CAP) { atomicAdd(&bar[XB_TMO], 1u); break; } }
    }
    nloc = mine > 0u ? mine : 1u; nx = cnt > 0u ? cnt : 1u;
}

__device__ __forceinline__ void xcd_barrier(const XcdBarrier& b) {
    asm volatile("s_waitcnt vmcnt(0)" ::: "memory");
    __syncthreads();
    if (threadIdx.x == 0) {
        unsigned* bar = b.bar;
        __builtin_amdgcn_s_waitcnt(0);
        unsigned nloc = b.st[0], nx = b.st[1];
        if (nloc == 0u) { xcd_barrier_complete(bar, b.x, nloc, nx); b.st[0] = nloc; b.st[1] = nx; }
        const unsigned old = xb_add(&bar[XB_XSUB(b.x)], 1u);
        const unsigned gen = old / nloc;
        if (old + 1u == (gen + 1u) * nloc) {
            __builtin_amdgcn_fence(__ATOMIC_RELEASE, "agent");
            asm volatile("s_waitcnt vmcnt(0)" ::: "memory");
            const unsigned og = xb_add(&bar[XB_TOP], 1u);
            const unsigned tg = og / nx;
            if (og + 1u == (tg + 1u) * nx) xb_add(&bar[XB_TOPGEN], 1u);
            else XB_SPIN(xb_ld(&bar[XB_TOPGEN]) == tg, bar);
            __builtin_amdgcn_fence(__ATOMIC_ACQUIRE, "agent");
            xb_add(&bar[XB_XGEN(b.x)], 1u);
            asm volatile("s_waitcnt vmcnt(0)" ::: "memory");
        } else {
            XB_SPIN(xb_ld(&bar[XB_XGEN(b.x)]) == gen, bar);
            __builtin_amdgcn_fence(__ATOMIC_ACQUIRE, "agent");
            asm volatile("s_waitcnt vmcnt(0)" ::: "memory");
        }
    }
    __syncthreads();
}

constexpr size_t WS_XBAR = 800u << 10;
static_assert(WS_XBAR >= WS_RSS2 + (size_t)MPAD * 4 && WS_XBAR + XCD_BAR_WORDS * 4 <= WS_TAB, "barrier words");
#ifndef PH_MASK
#define PH_MASK 0xff
#endif
struct Args { const float* in[20]; float* out; unsigned char* ws; };

__global__ void __launch_bounds__(512, 2) mega_fwd(Args a) {
    extern __shared__ __attribute__((aligned(16))) unsigned char lds[];
    cg::grid_group grid = cg::this_grid();
    volatile LAS unsigned* xb_st = (volatile LAS unsigned*)((LAS unsigned char*)lds + (LDS_BYTES - 128));
    if (threadIdx.x < 2) xb_st[threadIdx.x] = 0u;
    __syncthreads();
#define TID_DEFS const int tid = threadIdx.x, lane = tid & 63, wave = __builtin_amdgcn_readfirstlane(tid >> 6); const int G = gridDim.x, gw = blockIdx.x * 8 + wave, NGW = G * 8; (void)lane; (void)gw; (void)NGW; (void)G
#define WSP(T, off) ((T*)(a.ws + (off)))
#define Win_t WSP(bf16, WS_WIN)
#define Wo_t WSP(bf16, WS_WO)
#define Wg_t WSP(bf16, WS_WG)
#define Wu_t WSP(bf16, WS_WU)
#define Wd_t WSP(bf16, WS_WD)
#define XN WSP(bf16, WS_XN)
#define MIX WSP(bf16, WS_XN)
#define HB WSP(bf16, WS_HB)
#define ACT WSP(bf16, WS_ACT)
#define GLO WSP(bf16, WS_GLO)
#define GHI ((bf16*)a.out)
#define QA WSP(bf16, WS_QA)
#define KA WSP(bf16, WS_KA)
#define VA WSP(bf16, WS_VA)
#define QB WSP(bf16, WS_QB)
#define KB WSP(bf16, WS_KB)
#define VB WSP(bf16, WS_VB)
#define cosA WSP(float, WS_TAB)
#define sinA WSP(float, WS_TAB + TAB_BYTES)
#define cosB WSP(float, WS_TAB + 2 * TAB_BYTES)
#define sinB WSP(float, WS_TAB + 3 * TAB_BYTES)
#define rss1 WSP(float, WS_RSS1)
#define rss2 WSP(float, WS_RSS2)
#define ctl WSP(unsigned, WS_CTL)
#define KMAX2 WSP(float, WS_CTL + 2048)

#if PH_MASK & (1 << 0)
    {
        TID_DEFS;
        LAS float* scr = (LAS float*)((LAS unsigned char*)lds + wave * 16384);
        constexpr int I_IN = (DM / 64) * (INC / 32), I_O = (DM / 64) * (DM / 32), I_G = (DM / 64) * (FF / 32), I_D = (FF / 64) * (DM / 32);
        constexpr int NITEMS = I_IN + I_O + 2 * I_G + I_D;
        for (int it = gw; it < NITEMS; it += NGW) {
            int r = it;
            if (r < I_IN) { transpose_item(a.in[4], DM, INC, Win_t, nullptr, true, scr, r, lane); continue; } r -= I_IN;
            if (r < I_O) { transpose_item(a.in[12], DM, DM, Wo_t, nullptr, false, scr, r, lane); continue; } r -= I_O;
            if (r < I_G) { transpose_item(a.in[14], DM, FF, Wg_t, a.in[13], false, scr, r, lane); continue; } r -= I_G;
            if (r < I_G) { transpose_item(a.in[15], DM, FF, Wu_t, a.in[13], false, scr, r, lane); continue; } r -= I_G;
            transpose_item(a.in[18], FF, DM, Wd_t, nullptr, false, scr, r, lane);
        }
        const f32x4* gm = (const f32x4*)a.in[3] + lane;
        const f32x4 g0 = gm[0], g1 = gm[64], g2 = gm[128], g3 = gm[192];
        static_assert(MPAD % 4 == 0, "four rows per wave trip");
        for (int m0 = gw * 4; m0 < MPAD; m0 += NGW * 4) {
            f32x4 v[4][4];
#pragma unroll
            for (int r = 0; r < 4; ++r) {
                const int m = m0 + r < MROWS ? m0 + r : 0;
                const RowInfo ri = rowinfo(m);
                const float* hp = ri.pos < 16 ? a.in[2] + (size_t)ri.pos * DM : (ri.grp ? a.in[1] : a.in[0]) + (size_t)ri.xrow * DM;
                const f32x4* xr = (const f32x4*)hp + lane;
#pragma unroll
                for (int j = 0; j < 4; ++j) v[r][j] = xr[64 * j];
            }
#pragma unroll
            for (int r = 0; r < 4; ++r) {
                float s2 = 0.f;
#pragma unroll
                for (int j = 0; j < 4; ++j) s2 += (v[r][j].x * v[r][j].x + v[r][j].y * v[r][j].y) + (v[r][j].z * v[r][j].z + v[r][j].w * v[r][j].w);
                const float rstd = (m0 + r < MROWS) ? rsqrtf(wave_sum(s2) * (1.f / DM) + NORM_EPS) : 0.f;
                unsigned long long* o8 = (unsigned long long*)(XN + (size_t)(m0 + r) * DM) + lane;
                const f32x4 y0 = v[r][0] * g0 * rstd, y1 = v[r][1] * g1 * rstd, y2 = v[r][2] * g2 * rstd, y3 = v[r][3] * g3 * rstd;
                o8[0] = (unsigned long long)pk2(y0.x, y0.y) | ((unsigned long long)pk2(y0.z, y0.w) << 32);
                o8[64] = (unsigned long long)pk2(y1.x, y1.y) | ((unsigned long long)pk2(y1.z, y1.w) << 32);
                o8[128] = (unsigned long long)pk2(y2.x, y2.y) | ((unsigned long long)pk2(y2.z, y2.w) << 32);
                o8[192] = (unsigned long long)pk2(y3.x, y3.y) | ((unsigned long long)pk2(y3.z, y3.w) << 32);
            }
        }
        const int gt = blockIdx.x * 512 + tid, NGT = G * 512;
        for (int e = gt; e < L_P * 32; e += NGT) {
            const int pos = e >> 5, i = e & 31;
            float s, c;
            sincos_d((double)pos * INVB[i], s, c); cosB[e] = c; sinB[e] = s;
            if (pos < 16) { cosA[e] = 1.f; sinA[e] = 0.f; }
            else { const int t = pos - 16; const int rc = i < 16 ? (t >> 6) : (t & 63); sincos_d((double)rc * INVB[2 * (i & 15)], s, c); cosA[e] = c; sinA[e] = s; }
        }
        for (int e = gt; e < 2 * MPAD; e += NGT) rss1[e] = 0.f;
        if (gt == 0) ctl[0] = 0u;
        if (gt < 400) KMAX2[gt] = 0.f;
        for (int e = gt; e < XCD_BAR_WORDS; e += NGT) WSP(unsigned, WS_XBAR)[e] = 0u;
    }
#endif
    grid.sync();
    const XcdBarrier xb = xcd_barrier_post(WSP(unsigned, WS_XBAR), xb_st);

#if PH_MASK & (1 << 1)
    {
        TID_DEFS;
        pg8::Gemm g{XN, Win_t, MPAD, INC, DM}; pg8::StaticOrder S; S.init(MPAD, INC, G, (int)blockIdx.x);
        pg8::EpiQKV E{QA, KA, VA, QB, KB, VB, cosA, sinA, cosB, sinB, a.in[5], a.in[6], KMAX2};
#if defined(DUP_P1)
        int nrep = 2; asm volatile("" : "+s"(nrep));
        for (int rep = 0; rep < nrep; ++rep)
#endif
        pg8::gemm_phase<pg8::EpiQKV, pg8::StaticOrder, true, true>((LAS unsigned char*)lds, g, S, E);
    }
#endif
    xcd_barrier(xb);

#if PH_MASK & (1 << 2)
    {
        TID_DEFS;
        const float s1 = wave_sum(a.in[7][lane] * a.in[8][lane]), s2 = wave_sum(a.in[9][lane] * a.in[10][lane]);
        const float lam = __expf(s1) - __expf(s2) + 0.2f;
        const att::AttnArgs A{QA, KA, VA, QB, KB, VB, MIX, a.in[11], KMAX2};
        att::attn_phase(A, (char*)lds, ctl, lam);
    }
#endif
    xcd_barrier(xb);

#if PH_MASK & (1 << 3)
    {
        TID_DEFS;
        pg8::Gemm g{MIX, Wo_t, MPAD, DM, DM}; pg8::StaticOrder S; S.init(MPAD, DM, G, (int)blockIdx.x);
        pg8::EpiWo E{a.in[0], a.in[1], a.in[2], HB, rss1};
        pg8::gemm_phase<pg8::EpiWo, pg8::StaticOrder, true, true>((LAS unsigned char*)lds, g, S, E);
    }
#endif
    xcd_barrier(xb);

#if PH_MASK & (1 << 4)
    {
        TID_DEFS;
        pg8::Gemm g{HB, Wg_t, MPAD, FF, DM}; pg8::StaticOrder S; S.init(MPAD, FF, G, (int)blockIdx.x);
        pg8::EpiGate E{GLO, GHI, rss1};
#if defined(DUP_P4)
        int nrep = 2; asm volatile("" : "+s"(nrep));
        for (int rep = 0; rep < nrep; ++rep)
#endif
        pg8::gemm_phase<pg8::EpiGate, pg8::StaticOrder, true, true>((LAS unsigned char*)lds, g, S, E);
    }
#endif
    xcd_barrier(xb);

#if PH_MASK & (1 << 5)
    {
        TID_DEFS;
        pg8::Gemm g{HB, Wu_t, MPAD, FF, DM}; pg8::StaticOrder S; S.init(MPAD, FF, G, (int)blockIdx.x);
        pg8::EpiUp E{GLO, GHI, rss1, a.in[16], a.in[17], ACT};
#if defined(DUP_P5)
        int nrep = 2; asm volatile("" : "+s"(nrep));
        for (int rep = 0; rep < nrep; ++rep)
#endif
        pg8::gemm_phase<pg8::EpiUp, pg8::StaticOrder, true, true>((LAS unsigned char*)lds, g, S, E);
    }
#endif
    xcd_barrier(xb);

#if PH_MASK & (1 << 6)
    {
        TID_DEFS;
        pg8::Gemm g{ACT, Wd_t, MPAD, DM, FF}; pg8::StaticOrder S; S.init(MPAD, DM, G, (int)blockIdx.x);
        pg8::EpiDown E{HB, a.out, rss2};
        pg8::gemm_phase<pg8::EpiDown, pg8::StaticOrder, true, true>((LAS unsigned char*)lds, g, S, E);
    }
#endif
    xcd_barrier(xb);

#if PH_MASK & (1 << 7)
    {
        TID_DEFS;
        const f32x4* gf = (const f32x4*)a.in[19] + lane;
        const f32x4 g0 = gf[0], g1 = gf[64], g2 = gf[128], g3 = gf[192];
        static_assert(OUT_ROWS % 4 == 0, "four rows per wave trip");
        for (int m0 = gw * 4; m0 < OUT_ROWS; m0 += NGW * 4) {
            f32x4 v[4][4]; float rs[4];
#pragma unroll
            for (int r = 0; r < 4; ++r) { const f32x4* xr = (const f32x4*)(a.out + (size_t)(m0 + r) * DM) + lane; rs[r] = rss2[m0 + r];
#pragma unroll
                for (int j = 0; j < 4; ++j) v[r][j] = xr[64 * j]; }
#pragma unroll
            for (int r = 0; r < 4; ++r) { f32x4* xr = (f32x4*)(a.out + (size_t)(m0 + r) * DM) + lane; const float rstd = rsqrtf(rs[r] * (1.f / DM) + NORM_EPS);
                xr[0] = v[r][0] * g0 * rstd; xr[64] = v[r][1] * g1 * rstd; xr[128] = v[r][2] * g2 * rstd; xr[192] = v[r][3] * g3 * rstd; }
        }
    }
#endif
}

extern "C" void kernel_launch(void* const* d_in, const int* in_sizes, int n_in, void* d_out, int out_size, void* d_ws, size_t ws_size, hipStream_t stream) {
    static int grid = 0;
    if (grid == 0) {
        if (n_in != 20 || out_size != OUT_ROWS * DM || ws_size < WS_END) { fprintf(stderr, "kernel_launch: unexpected shapes n_in %d out %d ws %zu (need %zu)\n", n_in, out_size, ws_size, (size_t)WS_END); grid = -1; return; }
        int dev = 0, cus = 0, per_cu = 0;
        hipGetDevice(&dev); hipDeviceGetAttribute(&cus, hipDeviceAttributeMultiprocessorCount, dev);
        hipFuncSetAttribute((const void*)mega_fwd, hipFuncAttributeMaxDynamicSharedMemorySize, LDS_BYTES);
        hipOccupancyMaxActiveBlocksPerMultiprocessor(&per_cu, (const void*)mega_fwd, 512, LDS_BYTES);
        if (per_cu < 1) { fprintf(stderr, "kernel_launch: occupancy query says %d blocks/CU\n", per_cu); per_cu = 1; }
        (void)hipGetLastError();
        grid = cus * 1;
    }
    if (grid < 0) return;
    Args a{};
    for (int i = 0; i < 20; ++i) a.in[i] = (const float*)d_in[i];
    a.out = (float*)d_out; a.ws = (unsigned char*)d_ws;
    void* args[] = {&a};
    hipError_t e = hipLaunchCooperativeKernel((const void*)mega_fwd, dim3(grid), dim3(512), args, LDS_BYTES, stream);
    if (e != hipSuccess) fprintf(stderr, "cooperative launch failed: %s (grid %d)\n", hipGetErrorString(e), grid);
}
```

```cpp
#include <hip/hip_runtime.h>
#include <hip/hip_bf16.h>
#include <hip/hip_cooperative_groups.h>
#include <cstdio>
#include <cstdint>
#include <cmath>
namespace cg = cooperative_groups;

constexpr int DM = 1024, FF = 2816, INC = 2304;
constexpr int NSEQ_P = 8, S_P = 4096, L_P = 4112, NSEQ_S = 32, S_S = 2048, L_S = 2064;
constexpr int ROWS_P = NSEQ_P * L_P;
constexpr int ROWS_S = NSEQ_S * L_S;
constexpr int MROWS = ROWS_P + ROWS_S;
constexpr int MPAD = 99072;
constexpr int OUT_ROWS_P = NSEQ_P * S_P;
constexpr int OUT_ROWS = OUT_ROWS_P + NSEQ_S * S_S;
constexpr float NORM_EPS = 1e-6f;
static_assert(MPAD % 256 == 0 && MPAD >= MROWS + 64, "pad");
static_assert(L_P % 64 == 16 && L_S % 64 == 16, "tail tile holds 16 keys");

struct RowInfo { int pos, L, xrow, grp, sidx; };
__device__ __forceinline__ RowInfo rowinfo(int row) {
    RowInfo r;
    if (row < ROWS_P) { const int s = row / L_P; r.pos = row - s * L_P; r.L = L_P; r.grp = 0; r.sidx = s; r.xrow = s * S_P + r.pos - 16; }
    else { const int q = row - ROWS_P; const int s = q / L_S; r.pos = q - s * L_S; r.L = L_S; r.grp = 1; r.sidx = NSEQ_P + s; r.xrow = s * S_S + r.pos - 16; }
    return r;
}
namespace pg8 {
#define PG8_LAS __attribute__((address_space(3)))
typedef unsigned short bf16_t;
typedef short bf16x8 __attribute__((ext_vector_type(8)));
typedef float f32x4 __attribute__((ext_vector_type(4)));
typedef unsigned u32x4 __attribute__((ext_vector_type(4)));
constexpr int BM = 256, BK = 64, HALF = 128, HTB = HALF * BK * 2  , STAGE_BYTES = 8 * HTB, NXCD = 8, WGM = 8;

__host__ __device__ __forceinline__ int lds_byte(int r, int c) { const int st = (r >> 4) * 2 + (c >> 5), rr = r & 15, cc = c & 31, ob = rr * 64 + cc * 2; return st * 1024 + (ob ^ (((ob >> 9) & 1) << 5)); }
__host__ __device__ __forceinline__ void stage_rc(int b, int& R, int& C) { const int st = b / 1024, sb = b % 1024, swz = sb ^ (((sb >> 9) & 1) << 5); R = (st >> 1) * 16 + swz / 64; C = (st & 1) * 32 + (swz % 64) / 2; }
__host__ __device__ __forceinline__ int perm32(int rho) { const int n = rho >> 4, i = rho & 15; return 8 * (i >> 2) + 4 * n + (i & 3); }

struct Unit { int pm, pn; };
struct Gemm { const bf16_t* A; const bf16_t* Bt; int M, N, K; };

struct StaticOrder {
    int nM, nN, nwg, G, c;
    __host__ __device__ void init(int M, int N, int G_, int c_) { nM = M / BM; nN = N / BM; nwg = nM * nN; G = G_; c = c_; }
    __host__ __device__ bool next(int i, Unit& u) const {
        const long L = (long)i * G + c; if (L >= nwg) return false;
        int wgid = (int)L; { const int q = nwg / NXCD, r = nwg % NXCD, xcd = wgid % NXCD, off = wgid / NXCD; wgid = (xcd < r ? xcd * (q + 1) : r * (q + 1) + (xcd - r) * q) + off; }
        const int nig = WGM * nN, gid = wgid / nig, fm = gid * WGM, gsz = (nM - fm) < WGM ? (nM - fm) : WGM;
        u.pm = fm + ((wgid % nig) % gsz); u.pn = (wgid % nig) / gsz; return true;
    }
    __device__ __forceinline__ void a_ready(const Unit&) const {}
    __device__ __forceinline__ void done(const Unit&) const {}
};

__device__ __forceinline__ unsigned cvt_pk_bf16(float lo, float hi) { unsigned r; asm volatile("v_cvt_pk_bf16_f32 %0, %1, %2" : "=v"(r) : "v"(lo), "v"(hi)); return r; }
typedef float f32x2 __attribute__((ext_vector_type(2)));
__device__ __forceinline__ f32x2 gelu_pk(f32x2 v) {
    const f32x2 av = __builtin_elementwise_abs(v), d = av * 0.2316418882f + 1.0f;
    f32x2 t; t.x = __builtin_amdgcn_rcpf(d.x); t.y = __builtin_amdgcn_rcpf(d.y);
    f32x2 q = t * 0.5307027145f + (-0.7265760135f); q = q * t + 0.7107068705f; q = q * t + (-0.142248368f); q = q * t + 0.127414796f; q = q * t;
    const f32x2 s = (v * v) * (-0.72134752044f);
    f32x2 e; e.x = __builtin_amdgcn_exp2f(s.x); e.y = __builtin_amdgcn_exp2f(s.y);
    const f32x2 m = v * (q * e), r = v - m;
    f32x2 o; o.x = v.x < 0.f ? m.x : r.x; o.y = v.y < 0.f ? m.y : r.y; return o;
}
__device__ __forceinline__ u32x4 pack8(const f32x4 a, const f32x4 b) { u32x4 w; w.x = cvt_pk_bf16(a[0], a[1]); w.y = cvt_pk_bf16(a[2], a[3]); w.z = cvt_pk_bf16(b[0], b[1]); w.w = cvt_pk_bf16(b[2], b[3]); return w; }
__device__ __forceinline__ float bflo(unsigned w) { return __uint_as_float(w << 16); }
__device__ __forceinline__ float bfhi(unsigned w) { return __uint_as_float(w & 0xffff0000u); }
__device__ __forceinline__ float dot4(const f32x4 a) { return (a[0] * a[0] + a[1] * a[1]) + (a[2] * a[2] + a[3] * a[3]); }

struct EpiQKV {
    static constexpr bool PERM = true, AFTER_DRAIN = false;
    bf16_t *QA, *KA, *VA, *QB, *KB, *VB; const float *cosA, *sinA, *cosB, *sinB, *gq, *gk; float* kmax2;
    __device__ __forceinline__ void operator()(const f32x4 (&acc)[2][2][4][2], const Unit& u, int wr, int wc, int fr, int fq) const {
        const int g = u.pn * 4 + wc;
        bf16_t* dst; int ldc, col; const float* gn = nullptr; const float* ct = nullptr; const float* st = nullptr;
        float qsc = 1.f; int kst = -1, kmul = 0;
        if (g < 8) { dst = QA; ldc = 512; col = 64 * g; gn = gq; ct = cosA; st = sinA; qsc = 0.125f * 1.4426950408889634f; }
        else if (g < 10) { dst = KA; ldc = 128; col = 64 * (g - 8); gn = gk; ct = cosA; st = sinA; kst = g - 8; kmul = 2; }
        else if (g < 12) { dst = VA; ldc = 128; col = 64 * (g - 10); }
        else if (g < 20) { dst = QB; ldc = 512; col = 64 * (g - 12); ct = cosB; st = sinB; qsc = 0.125f * 1.4426950408889634f; }
        else if (g < 28) { dst = KB; ldc = 512; col = 64 * (g - 20); ct = cosB; st = sinB; kst = 80 + (g - 20); kmul = 8; }
        else { dst = VB; ldc = 512; col = 64 * (g - 28); }
        f32x4 gv[2][2];
#pragma unroll
        for (int bj = 0; bj < 2; ++bj)
#pragma unroll
            for (int n = 0; n < 2; ++n) gv[bj][n] = gn ? *(const f32x4*)(gn + 32 * bj + 8 * fq + 4 * n) : (f32x4){1.f, 1.f, 1.f, 1.f};
#pragma unroll
        for (int ai = 0; ai < 2; ++ai)
#pragma unroll
            for (int m = 0; m < 4; ++m) {
                const int row = u.pm * BM + ai * HALF + wr * 64 + m * 16 + fr;
                f32x4 a0 = acc[ai][0][m][0], a1 = acc[ai][0][m][1], b0 = acc[ai][1][m][0], b1 = acc[ai][1][m][1];
                if (gn) {
                    float ss = (dot4(a0) + dot4(a1)) + (dot4(b0) + dot4(b1));
                    ss += __shfl_xor(ss, 16); ss += __shfl_xor(ss, 32);
                    const float r = rsqrtf(ss * (1.0f / 64.0f) + NORM_EPS);
                    a0 = a0 * r * gv[0][0]; a1 = a1 * r * gv[0][1]; b0 = b0 * r * gv[1][0]; b1 = b1 * r * gv[1][1];
                }
                if (ct) {
                    const RowInfo ri = rowinfo(row);
                    const float* cp = ct + ri.pos * 32 + 8 * fq; const float* sp = st + ri.pos * 32 + 8 * fq;
                    const f32x4 c0 = *(const f32x4*)cp, c1 = *(const f32x4*)(cp + 4), s0 = *(const f32x4*)sp, s1 = *(const f32x4*)(sp + 4);
                    const f32x4 y0 = a0 * c0 - b0 * s0, y1 = a1 * c1 - b1 * s1, z0 = b0 * c0 + a0 * s0, z1 = b1 * c1 + a1 * s1;
                    a0 = y0; a1 = y1; b0 = z0; b1 = z1;
                }
                a0 = a0 * qsc; a1 = a1 * qsc; b0 = b0 * qsc; b1 = b1 * qsc;
                if (kst >= 0) {
                    float kk = (dot4(a0) + dot4(a1)) + (dot4(b0) + dot4(b1));
                    kk += __shfl_xor(kk, 16); kk += __shfl_xor(kk, 32);
                    const RowInfo rk = rowinfo(row);
                    float* km = kmax2 + kst + kmul * rk.sidx;
                    if (fq == 0 && row < MROWS && kk > *km) atomicMax((unsigned*)km, __float_as_uint(kk));
                }
                bf16_t* p = dst + (size_t)row * ldc + col + 8 * fq;
                *(u32x4*)p = pack8(a0, a1); *(u32x4*)(p + 32) = pack8(b0, b1);
                asm volatile("" ::: "memory");
            }
    }
};

struct EpiWo {
    static constexpr bool PERM = true, AFTER_DRAIN = false;
    const float *xp, *xs, *meta; bf16_t* hb; float* rowss;
    __device__ __forceinline__ void operator()(const f32x4 (&acc)[2][2][4][2], const Unit& u, int wr, int wc, int fr, int fq) const {
        const int col0 = u.pn * BM + wc * 32 + 8 * fq;
#pragma unroll
        for (int ai = 0; ai < 2; ++ai)
#pragma unroll
            for (int m = 0; m < 4; ++m) {
                const int row = u.pm * BM + ai * HALF + wr * 64 + m * 16 + fr;
                const bool live = row < MROWS;
                const RowInfo ri = rowinfo(row);
                const float* hx = ri.grp ? xs : xp; asm volatile("" : "+v"(hx)); const float* hm = meta; asm volatile("" : "+v"(hm));
                const float* hp = ri.pos < 16 ? hm + (size_t)ri.pos * DM : hx + (size_t)ri.xrow * DM;
                float ss = 0.f;
#pragma unroll
                for (int bj = 0; bj < 2; ++bj) {
                    f32x4 v0 = acc[ai][bj][m][0], v1 = acc[ai][bj][m][1];
                    if (live) { v0 = v0 + *(const f32x4*)(hp + col0 + bj * HALF); v1 = v1 + *(const f32x4*)(hp + col0 + bj * HALF + 4); }
                    ss += dot4(v0) + dot4(v1);
                    *(u32x4*)(hb + (size_t)row * DM + col0 + bj * HALF) = pack8(v0, v1);
                }
                ss += __shfl_xor(ss, 16); ss += __shfl_xor(ss, 32);
                if (fq == 0 && live) atomicAdd(rowss + row, ss);
                asm volatile("" ::: "memory");
            }
    }
};

constexpr int GLO_LD = 1280, GHI_LD = 1536, GSPLIT = 5;
struct EpiGate {
    static constexpr bool PERM = true, AFTER_DRAIN = false;
    bf16_t *Glo, *Ghi; const float* rowss;
    __device__ __forceinline__ void operator()(const f32x4 (&acc)[2][2][4][2], const Unit& u, int wr, int wc, int fr, int fq) const {
        bf16_t* base; int ld, colt;
        if (u.pn < GSPLIT) { base = Glo; ld = GLO_LD; colt = u.pn * BM; } else { base = Ghi; ld = GHI_LD; colt = (u.pn - GSPLIT) * BM; }
        const int col0 = colt + wc * 32 + 8 * fq;
#pragma unroll
        for (int ai = 0; ai < 2; ++ai)
#pragma unroll
            for (int m = 0; m < 4; ++m) {
                const int row = u.pm * BM + ai * HALF + wr * 64 + m * 16 + fr;
                const float rs = rsqrtf(rowss[row] * (1.0f / DM) + NORM_EPS);
#pragma unroll
                for (int bj = 0; bj < 2; ++bj)
                    *(u32x4*)(base + (size_t)row * ld + col0 + bj * HALF) = pack8(acc[ai][bj][m][0] * rs, acc[ai][bj][m][1] * rs);
            }
    }
};

__device__ __forceinline__ void unpk8(const u32x4 g, f32x4& lo, f32x4& hi) {
    lo[0] = bflo(g.x); lo[1] = bfhi(g.x); lo[2] = bflo(g.y); lo[3] = bfhi(g.y); hi[0] = bflo(g.z); hi[1] = bfhi(g.z); hi[2] = bflo(g.w); hi[3] = bfhi(g.w);
}
struct EpiUp {
    static constexpr bool PERM = true, AFTER_DRAIN = false;
    const bf16_t *Glo, *Ghi; const float* rowss; const float *cw, *cb; bf16_t* act;
    __device__ __forceinline__ void operator()(const f32x4 (&acc)[2][2][4][2], const Unit& u, int wr, int wc, int fr, int fq) const {
        const bf16_t* base; int ld, colt;
        if (u.pn < GSPLIT) { base = Glo; ld = GLO_LD; colt = u.pn * BM; } else { base = Ghi; ld = GHI_LD; colt = (u.pn - GSPLIT) * BM; }
        const int gcol0 = colt + wc * 32 + 8 * fq, col0 = u.pn * BM + wc * 32 + 8 * fq;
#pragma unroll
        for (int ai = 0; ai < 2; ++ai)
#pragma unroll
            for (int m = 0; m < 4; ++m) {
                const int row = u.pm * BM + ai * HALF + wr * 64 + m * 16 + fr;
                const RowInfo ri = rowinfo(row);
                const bool hp = ri.pos > 0, hn = ri.pos < ri.L - 1;
                const float fp = hp ? 1.f : 0.f, fn = hn ? 1.f : 0.f;
                const float rs = rsqrtf(rowss[row] * (1.0f / DM) + NORM_EPS);
                const bf16_t* gp0 = base + (size_t)row * ld + gcol0;
                const int dm = hp ? -ld : 0, dx = hn ? ld : 0;
#pragma unroll
                for (int bj = 0; bj < 2; ++bj) {
                    const bf16_t* gp = gp0 + bj * HALF;
                    const u32x4 gc = *(const u32x4*)gp, gm = *(const u32x4*)(gp + dm), gx = *(const u32x4*)(gp + dx);
                    const float* wp = cw + col0 + bj * HALF;
                    f32x4 c0, c1, p0, p1, n0, n1; unpk8(gc, c0, c1); unpk8(gm, p0, p1); unpk8(gx, n0, n1);
                    f32x4 t0 = *(const f32x4*)(cb + col0 + bj * HALF) + *(const f32x4*)(wp + FF) * c0 + (*(const f32x4*)wp * p0) * fp + (*(const f32x4*)(wp + 2 * FF) * n0) * fn;
                    f32x4 t1 = *(const f32x4*)(cb + col0 + bj * HALF + 4) + *(const f32x4*)(wp + FF + 4) * c1 + (*(const f32x4*)(wp + 4) * p1) * fp + (*(const f32x4*)(wp + 2 * FF + 4) * n1) * fn;
                    const f32x2 ga = gelu_pk((f32x2){t0[0], t0[1]}), gb = gelu_pk((f32x2){t0[2], t0[3]}), gc2 = gelu_pk((f32x2){t1[0], t1[1]}), gd = gelu_pk((f32x2){t1[2], t1[3]});
                    const f32x4 u0 = acc[ai][bj][m][0] * rs, u1 = acc[ai][bj][m][1] * rs;
                    const f32x4 r0 = (f32x4){ga.x, ga.y, gb.x, gb.y} * u0, r1 = (f32x4){gc2.x, gc2.y, gd.x, gd.y} * u1;
                    *(u32x4*)(act + (size_t)row * FF + col0 + bj * HALF) = pack8(r0, r1);
                    asm volatile("" ::: "memory");
                }
            }
    }
};

struct EpiDown {
    static constexpr bool PERM = true, AFTER_DRAIN = false;
    const bf16_t* hb; float* out; float* rowss2;
    __device__ __forceinline__ void operator()(const f32x4 (&acc)[2][2][4][2], const Unit& u, int wr, int wc, int fr, int fq) const {
        const int col0 = u.pn * BM + wc * 32 + 8 * fq;
#pragma unroll
        for (int ai = 0; ai < 2; ++ai)
#pragma unroll
            for (int m = 0; m < 4; ++m) {
                const int row = u.pm * BM + ai * HALF + wr * 64 + m * 16 + fr;
                const RowInfo ri = rowinfo(row);
                const bool live = row < MROWS && ri.pos >= 16;
                const int orow = (ri.grp ? OUT_ROWS_P : 0) + ri.xrow;
                float ss = 0.f;
#pragma unroll
                for (int bj = 0; bj < 2; ++bj) {
                    if (live) {
                        const u32x4 h = *(const u32x4*)(hb + (size_t)row * DM + col0 + bj * HALF);
                        f32x4 v0 = acc[ai][bj][m][0], v1 = acc[ai][bj][m][1];
                        v0[0] += bflo(h.x); v0[1] += bfhi(h.x); v0[2] += bflo(h.y); v0[3] += bfhi(h.y); v1[0] += bflo(h.z); v1[1] += bfhi(h.z); v1[2] += bflo(h.w); v1[3] += bfhi(h.w);
                        ss += dot4(v0) + dot4(v1);
                        float* op = out + (size_t)orow * DM + col0 + bj * HALF;
                        *(f32x4*)op = v0; *(f32x4*)(op + 4) = v1;
                    }
                }
                ss += __shfl_xor(ss, 16); ss += __shfl_xor(ss, 32);
                if (fq == 0 && live) atomicAdd(rowss2 + orow, ss);
                asm volatile("" ::: "memory");
            }
    }
};
template <class Epi, class Sched, bool ALIGN_EPI = false, bool SP2 = false>
__device__ __forceinline__ void gemm_phase(PG8_LAS unsigned char* lds, const Gemm g, const Sched& S, const Epi& E) {
    int tid_ = threadIdx.x; asm volatile("" : "+v"(tid_));
    const int tid = tid_, wid = __builtin_amdgcn_readfirstlane(tid >> 6), lane = tid & 63, wr = wid >> 2, wc = wid & 3, fr = lane & 15, fq = lane >> 4;
    const int K = g.K, nt = K / BK;
    unsigned voffA[2], voffB[2];
#pragma unroll
    for (int i = 0; i < 2; ++i) { int R, C; stage_rc(tid * 16 + i * 8192, R, C); const int Rb = Epi::PERM ? ((R & ~31) + perm32(R & 31)) : R;
        voffA[i] = (unsigned)(R * K + C) * 2u; voffB[i] = (unsigned)(Rb * K + C) * 2u; }
    const size_t kstep = (size_t)(BK * 2);
    const size_t hstep = (size_t)HALF * K * 2;
    const size_t tstep = 2 * hstep;
    const unsigned ldsw = (unsigned)wid * 1024u;
    const int aoff = lds_byte(wr * 64 + fr, fq * 8), boff = lds_byte(wc * 32 + fr, fq * 8);
#define PG8_SA(b, h) (((b) * 2 + (h)) * HTB)
#define PG8_SB(b, h) ((4 + (b) * 2 + (h)) * HTB)
#define PG8_STAGE(bufoff, gbase, voff) do { _Pragma("unroll") for (int _i = 0; _i < 2; ++_i) \
        __builtin_amdgcn_global_load_lds((const unsigned*)((const char*)(gbase) + (voff)[_i]), (PG8_LAS unsigned*)(lds + (bufoff) + ldsw + _i * 8192), 16, 0, 0); } while (0)
#define PG8_LDA(dst, b, h) do { _Pragma("unroll") for (int m = 0; m < 4; ++m) _Pragma("unroll") for (int k = 0; k < 2; ++k) dst[m][k] = *(const PG8_LAS bf16x8*)(lds + PG8_SA(b, h) + aoff + m * 2048 + k * 1024); } while (0)
#define PG8_LDB(dst, b, h) do { _Pragma("unroll") for (int n = 0; n < 2; ++n) _Pragma("unroll") for (int k = 0; k < 2; ++k) dst[n][k] = *(const PG8_LAS bf16x8*)(lds + PG8_SB(b, h) + boff + n * 2048 + k * 1024); } while (0)
#define PG8_MMA(ai, bj, At, Bt) do { __builtin_amdgcn_s_setprio(1); _Pragma("unroll") for (int m = 0; m < 4; ++m) _Pragma("unroll") for (int n = 0; n < 2; ++n) _Pragma("unroll") for (int k = 0; k < 2; ++k) \
        acc[ai][bj][m][n] = __builtin_amdgcn_mfma_f32_16x16x32_bf16(Bt[n][k], At[m][k], acc[ai][bj][m][n], 0, 0, 0); __builtin_amdgcn_s_setprio(0); } while (0)
#define PG8_WAIT_V(n) asm volatile("s_waitcnt vmcnt(" #n ")" ::: "memory")
#define PG8_WAIT_L(n) asm volatile("s_waitcnt lgkmcnt(" #n ")" ::: "memory")
#define PG8_BAR __builtin_amdgcn_s_barrier()
#define PG8_SCHED __builtin_amdgcn_sched_barrier(0)
    Unit cur, nxt; int ui = 0;
    if (!S.next(0, cur)) return;
    f32x4 acc[2][2][4][2];
#pragma unroll
    for (int a = 0; a < 2; ++a)
#pragma unroll
        for (int b = 0; b < 2; ++b)
#pragma unroll
            for (int m = 0; m < 4; ++m)
#pragma unroll
                for (int n = 0; n < 2; ++n) acc[a][b][m][n] = (f32x4){0.f, 0.f, 0.f, 0.f};
    bf16x8 At[4][2], B0[2][2], B1[2][2];
    const char* cA = (const char*)g.A + (size_t)cur.pm * tstep; const char* cB = (const char*)g.Bt + (size_t)cur.pn * tstep;
    S.a_ready(cur);
    if constexpr (SP2) {
        PG8_STAGE(PG8_SB(0, 0), cB, voffB); PG8_STAGE(PG8_SB(0, 1), cB + hstep, voffB); PG8_STAGE(PG8_SA(0, 0), cA, voffA); PG8_STAGE(PG8_SA(0, 1), cA + hstep, voffA);
        if (wr == 1) PG8_BAR;
        PG8_WAIT_V(2); PG8_BAR;
        PG8_STAGE(PG8_SB(1, 0), cB + kstep, voffB); PG8_STAGE(PG8_SA(1, 0), cA + kstep, voffA); PG8_STAGE(PG8_SB(1, 1), cB + hstep + kstep, voffB);
        PG8_WAIT_V(6); PG8_BAR;
    } else {
        PG8_STAGE(PG8_SB(0, 0), cB, voffB); PG8_STAGE(PG8_SA(0, 0), cA, voffA); PG8_STAGE(PG8_SB(0, 1), cB + hstep, voffB); PG8_STAGE(PG8_SA(0, 1), cA + hstep, voffA);
        if (wr == 1) PG8_BAR;
        PG8_WAIT_V(4); PG8_BAR;
        PG8_STAGE(PG8_SB(1, 0), cB + kstep, voffB); PG8_STAGE(PG8_SA(1, 0), cA + kstep, voffA); PG8_STAGE(PG8_SB(1, 1), cB + hstep + kstep, voffB);
        PG8_WAIT_V(6); PG8_BAR;
    }
    for (;;) {
        const bool has_next = S.next(ui + 1, nxt);
        const char* nA = has_next ? (const char*)g.A + (size_t)nxt.pm * tstep : cA; const char* nB = has_next ? (const char*)g.Bt + (size_t)nxt.pn * tstep : cB;
        for (int t = 0; t < nt; t += 2) {
            const bool last = (t == nt - 2);
            const char* a1 = cA + (size_t)(t + 1) * kstep;
            const char* a2 = last ? nA : cA + (size_t)(t + 2) * kstep; const char* b2 = last ? nB : cB + (size_t)(t + 2) * kstep;
            const char* a3 = a2 + kstep; const char* b3 = b2 + kstep;
            if (last && has_next) S.a_ready(nxt);
            if constexpr (SP2) {
            PG8_LDB(B0, 0, 0); PG8_LDB(B1, 0, 1); PG8_SCHED; PG8_LDA(At, 0, 0); PG8_STAGE(PG8_SA(1, 1), a1 + hstep, voffA);
            PG8_WAIT_V(8); PG8_WAIT_L(0); PG8_BAR; PG8_MMA(0, 0, At, B0); PG8_MMA(0, 1, At, B1); PG8_BAR; PG8_SCHED;
            PG8_LDA(At, 0, 1); PG8_STAGE(PG8_SB(0, 0), b2, voffB); PG8_STAGE(PG8_SB(0, 1), b2 + hstep, voffB); PG8_STAGE(PG8_SA(0, 0), a2, voffA);
            PG8_WAIT_V(8); PG8_WAIT_L(0); PG8_BAR; PG8_MMA(1, 0, At, B0); PG8_MMA(1, 1, At, B1); PG8_BAR; PG8_SCHED;
            PG8_LDB(B0, 1, 0); PG8_LDB(B1, 1, 1); PG8_SCHED; PG8_LDA(At, 1, 0); PG8_STAGE(PG8_SA(0, 1), a2 + hstep, voffA);
            PG8_WAIT_V(8); PG8_WAIT_L(0); PG8_BAR; PG8_MMA(0, 0, At, B0); PG8_MMA(0, 1, At, B1); PG8_BAR; PG8_SCHED;
            PG8_LDA(At, 1, 1); PG8_STAGE(PG8_SB(1, 0), b3, voffB); PG8_STAGE(PG8_SB(1, 1), b3 + hstep, voffB); PG8_STAGE(PG8_SA(1, 0), a3, voffA);
            PG8_WAIT_V(8); PG8_WAIT_L(0); PG8_BAR; PG8_MMA(1, 0, At, B0); PG8_MMA(1, 1, At, B1); PG8_BAR; PG8_SCHED;
            } else {
            PG8_LDB(B0, 0, 0); PG8_SCHED; PG8_LDA(At, 0, 0); PG8_STAGE(PG8_SA(1, 1), a1 + hstep, voffA);
            PG8_WAIT_L(8); PG8_BAR; PG8_WAIT_L(0); PG8_MMA(0, 0, At, B0); PG8_BAR; PG8_SCHED;
            PG8_LDB(B1, 0, 1); PG8_STAGE(PG8_SB(0, 0), b2, voffB);
            PG8_BAR; PG8_WAIT_L(0); PG8_MMA(0, 1, At, B1); PG8_BAR;
            PG8_LDA(At, 0, 1); PG8_STAGE(PG8_SA(0, 0), a2, voffA);
            PG8_BAR; PG8_WAIT_L(0); PG8_MMA(1, 0, At, B0); PG8_BAR; PG8_SCHED;
            PG8_STAGE(PG8_SB(0, 1), b2 + hstep, voffB);
            PG8_WAIT_V(6); PG8_BAR; PG8_MMA(1, 1, At, B1); PG8_BAR;
            PG8_LDB(B0, 1, 0); PG8_SCHED; PG8_LDA(At, 1, 0); PG8_STAGE(PG8_SA(0, 1), a2 + hstep, voffA);
            PG8_WAIT_L(8); PG8_BAR; PG8_WAIT_L(0); PG8_MMA(0, 0, At, B0); PG8_BAR; PG8_SCHED;
            PG8_LDB(B1, 1, 1); PG8_STAGE(PG8_SB(1, 0), b3, voffB);
            PG8_BAR; PG8_WAIT_L(0); PG8_MMA(0, 1, At, B1); PG8_BAR;
            PG8_LDA(At, 1, 1); PG8_STAGE(PG8_SA(1, 0), a3, voffA);
            PG8_BAR; PG8_WAIT_L(0); PG8_MMA(1, 0, At, B0); PG8_BAR; PG8_SCHED;
            PG8_STAGE(PG8_SB(1, 1), b3 + hstep, voffB);
            PG8_WAIT_V(6); PG8_BAR; PG8_MMA(1, 1, At, B1); PG8_BAR;
            }
        }
        if constexpr (ALIGN_EPI) { if (wr == 0) PG8_BAR; }
        if constexpr (!Epi::AFTER_DRAIN) { E(acc, cur, wr, wc, fr, fq); S.done(cur); }
        if (!has_next) break;
#pragma unroll
        for (int a = 0; a < 2; ++a)
#pragma unroll
            for (int b = 0; b < 2; ++b)
#pragma unroll
                for (int m = 0; m < 4; ++m)
#pragma unroll
                    for (int n = 0; n < 2; ++n) acc[a][b][m][n] = (f32x4){0.f, 0.f, 0.f, 0.f};
        cur = nxt; cA = nA; cB = nB; ++ui;
        if constexpr (ALIGN_EPI) { if (wr == 1) PG8_BAR; }
    }
    PG8_WAIT_V(0);
    if constexpr (!ALIGN_EPI) { if (wr == 0) PG8_BAR; }
    PG8_BAR;
    if constexpr (Epi::AFTER_DRAIN) { E.fused(acc, cur, wr, wc, fr, fq, lds, wid, lane); S.done(cur); }
#undef PG8_SA
#undef PG8_SB
#undef PG8_STAGE
#undef PG8_LDA
#undef PG8_LDB
#undef PG8_MMA
#undef PG8_WAIT_V
#undef PG8_WAIT_L
#undef PG8_BAR
#undef PG8_SCHED
}
}
namespace ab {
using bf16=unsigned short;
using bf16x8=__attribute__((ext_vector_type(8)))short;
using s16x4=__attribute__((ext_vector_type(4)))short;
using f32x16=__attribute__((ext_vector_type(16)))float;
using u32x4=__attribute__((ext_vector_type(4)))unsigned;
constexpr int D=64, QP=512, KP=128, OP=1024;
constexpr int NW=8,QBLK=32,QB=QBLK*NW,KVBLK=64;
__device__ __forceinline__ int crow(int r,int hi){return (r&3)+8*(r>>2)+4*hi;}
#define SBAR() __builtin_amdgcn_sched_barrier(0)
__device__ __forceinline__ void cmask(f32x16&p0,f32x16&p1,int jb,int qrel,int hi){
  const float NEG=-INFINITY; (void)qrel; (void)hi;
  if(jb==2){
    #pragma unroll
    for(int r=8;r<16;++r)p0[r]=NEG;
    #pragma unroll
    for(int r=0;r<16;++r)p1[r]=NEG;
  } else if(jb==3){
    #pragma unroll
    for(int r=0;r<16;++r){p0[r]=NEG;p1[r]=NEG;}
  }
}

constexpr int NSLOT=3, SLOTB=8192;
constexpr int LDS_K=0, LDS_V=NSLOT*SLOTB, LDS_WS=2*NSLOT*SLOTB, LDS_OST=LDS_WS+NW*64*4, LDS_BYTES=LDS_OST+NW*4096;
constexpr float C2=0.125f*1.4426950408889634f;
__device__ __forceinline__ void glds16(const void*gsrc,unsigned lds_dst){unsigned keep;
  asm volatile("s_mov_b32 %0, m0\n\ts_mov_b32 m0, %2\n\ts_nop 0\n\tglobal_load_lds_dwordx4 %1, off\n\ts_mov_b32 m0, %0":"=&s"(keep):"v"(gsrc),"s"(lds_dst):"memory");}
__device__ __forceinline__ float max3f(float a,float b,float c){float r;asm("v_max3_f32 %0, %1, %2, %3":"=v"(r):"v"(a),"v"(b),"v"(c));return r;}
__device__ __forceinline__ float max2f(float a,float b){float r;asm("v_max_f32_e32 %0, %1, %2":"=v"(r):"v"(a),"v"(b));return r;}
__device__ __forceinline__ float fadd_s(float a,float b){float r;asm("v_add_f32_e32 %0, %1, %2":"=v"(r):"v"(a),"v"(b));return r;}
__device__ __forceinline__ float fsub_s(float a,float b){float r;asm("v_sub_f32_e32 %0, %1, %2":"=v"(r):"v"(a),"v"(b));return r;}
typedef float f32x2_t __attribute__((ext_vector_type(2))); typedef __bf16 bf16x2_t __attribute__((ext_vector_type(2)));
__device__ __forceinline__ unsigned cvtpk_s(float lo,float hi){f32x2_t v={lo,hi};bf16x2_t b=__builtin_convertvector(v,bf16x2_t);return __builtin_bit_cast(unsigned,b);}
#define WAIT_BAR(N) asm volatile("s_waitcnt vmcnt(" #N ") lgkmcnt(0)\n\ts_barrier":::"memory")

__device__ __forceinline__ void qkt(f32x16&p0,f32x16&p1,const char*Kslot,const bf16x8*qr,const f32x16&negm,int r32,int hi){
  const char*kb=Kslot+hi*1024+r32*16;
  #pragma unroll
  for(int d0=0;d0<4;++d0){
    const bf16x8 b0=*reinterpret_cast<const bf16x8*>(kb+d0*2048);
    const bf16x8 b1=*reinterpret_cast<const bf16x8*>(kb+d0*2048+512);
    if(d0==0){p0=__builtin_amdgcn_mfma_f32_32x32x16_bf16(b0,qr[0],negm,0,0,0);p1=__builtin_amdgcn_mfma_f32_32x32x16_bf16(b1,qr[0],negm,0,0,0);}
    else{p0=__builtin_amdgcn_mfma_f32_32x32x16_bf16(b0,qr[d0],p0,0,0,0);p1=__builtin_amdgcn_mfma_f32_32x32x16_bf16(b1,qr[d0],p1,0,0,0);}}
}
typedef __attribute__((address_space(3))) const char* lds_cptr;
typedef short v4i16_t __attribute__((ext_vector_type(4)));
__device__ __forceinline__ void kload8(bf16x8*kf,lds_cptr kp){
  kf[0]=*(const __attribute__((address_space(3))) bf16x8*)(kp);      kf[1]=*(const __attribute__((address_space(3))) bf16x8*)(kp+512);
  kf[2]=*(const __attribute__((address_space(3))) bf16x8*)(kp+2048); kf[3]=*(const __attribute__((address_space(3))) bf16x8*)(kp+2560);
  kf[4]=*(const __attribute__((address_space(3))) bf16x8*)(kp+4096); kf[5]=*(const __attribute__((address_space(3))) bf16x8*)(kp+4608);
  kf[6]=*(const __attribute__((address_space(3))) bf16x8*)(kp+6144); kf[7]=*(const __attribute__((address_space(3))) bf16x8*)(kp+6656);
}
__device__ __forceinline__ void kload2(bf16x8*kf,lds_cptr kp,int j){ kf[2*j]=*(const __attribute__((address_space(3))) bf16x8*)(kp+j*2048); kf[2*j+1]=*(const __attribute__((address_space(3))) bf16x8*)(kp+j*2048+512); }
__device__ __forceinline__ s16x4 vtr(lds_cptr p){ return __builtin_bit_cast(s16x4,__builtin_amdgcn_ds_read_tr16_b64_v4i16((__attribute__((address_space(3))) v4i16_t*)p)); }
__device__ __forceinline__ float rowmax(const f32x16&p0,const f32x16&p1){
  float a=max3f(p0[0],p0[1],p1[0]),b=max3f(p0[2],p0[3],p1[1]);a=max3f(a,p1[2],p1[3]);
  #pragma unroll
  for(int r=4;r<16;r+=4){a=max3f(a,p0[r],p0[r+1]);b=max3f(b,p0[r+2],p0[r+3]);a=max3f(a,p1[r],p1[r+1]);b=max3f(b,p1[r+2],p1[r+3]);}
  const float m=max2f(a,b);
  auto rr=__builtin_amdgcn_permlane32_swap(__float_as_uint(m),__float_as_uint(m),false,false);
  return max2f(__uint_as_float(rr[0]),__uint_as_float(rr[1]));
}
__device__ __forceinline__ void pv(f32x16*o,int vb,bf16x8 pa0,bf16x8 pa1,bf16x8 pa2,bf16x8 pa3){
  #pragma unroll
  for(int d0=0;d0<2;++d0){s16x4 lo[4],hi[4];
    #pragma unroll
    for(int ks=0;ks<4;++ks){
      asm volatile("ds_read_b64_tr_b16 %0,%1 offset:%c2":"=&v"(lo[ks]):"v"(vb),"i"(d0*4096+ks*1024):"memory");
      asm volatile("ds_read_b64_tr_b16 %0,%1 offset:%c2":"=&v"(hi[ks]):"v"(vb),"i"(d0*4096+ks*1024+512):"memory");}
    asm volatile("s_waitcnt lgkmcnt(0)":::"memory");SBAR();
    #define PK(k) (bf16x8){lo[k][0],lo[k][1],lo[k][2],lo[k][3],hi[k][0],hi[k][1],hi[k][2],hi[k][3]}
    o[d0]=__builtin_amdgcn_mfma_f32_32x32x16_bf16(pa0,PK(0),o[d0],0,0,0);
    o[d0]=__builtin_amdgcn_mfma_f32_32x32x16_bf16(pa1,PK(1),o[d0],0,0,0);
    o[d0]=__builtin_amdgcn_mfma_f32_32x32x16_bf16(pa2,PK(2),o[d0],0,0,0);
    o[d0]=__builtin_amdgcn_mfma_f32_32x32x16_bf16(pa3,PK(3),o[d0],0,0,0);
    #undef PK
  }
}

#ifndef ATTN_STORE16
#define ATTN_STORE16(p,v) (*(u32x4*)(p)=(v))
#endif
template<int THRL> __device__ __forceinline__ void attn_unit(const bf16*Qw0,const bf16*__restrict__ Kh,const bf16*__restrict__ Vh,bf16*Ow0,int NT,char*shm){
  int tid_=threadIdx.x; asm volatile("":"+v"(tid_));
  const int tid=tid_,lane=tid&63,r32=lane&31,hi=lane>>5; const int wid=__builtin_amdgcn_readfirstlane(tid>>6);
  const bf16*Qw=Qw0+(long)(wid*QBLK)*QP;
  const unsigned lds0=(unsigned)(uintptr_t)shm;
  float*wsf=(float*)(shm+LDS_WS)+wid*64;
  const bf16*ksrc=Kh+(long)lane*KP+wid*8;
  const bf16*vsrc=Vh+(long)(16*(wid&3)+(lane>>2))*KP+(wid>>2)*32+(lane&3)*8;
  const unsigned kdst=lds0+LDS_K+wid*1024, vdst=lds0+LDS_V+wid*1024;
  #define DMA_K(t,slot) glds16(ksrc+(long)(t)*KVBLK*KP,(unsigned)__builtin_amdgcn_readfirstlane(kdst+(slot)))
  #define DMA_V(t,slot) glds16(vsrc+(long)(t)*KVBLK*KP,(unsigned)__builtin_amdgcn_readfirstlane(vdst+(slot)))
  const int vb0=(int)(lds0+LDS_V)+((lane>>4)&1)*32+(lane&3)*8+(4*hi+((lane&15)>>2))*64;
  const char*Kbase=shm+LDS_K; bf16x8 kf[8];
  const lds_cptr shm3=(lds_cptr)shm; const lds_cptr kp0=shm3+LDS_K+hi*1024+r32*16; const lds_cptr vp0=shm3+LDS_V+((lane>>4)&1)*32+(lane&3)*8+(4*hi+((lane&15)>>2))*64;
  DMA_K(0,0);DMA_V(0,0);DMA_K(1,SLOTB);
  bf16x8 qr[4];
  #pragma unroll
  for(int d0=0;d0<4;++d0)qr[d0]=*reinterpret_cast<const bf16x8*>(&Qw[(long)r32*QP+d0*16+hi*8]);
  float mhat=0.f,l_reg=0.f;f32x16 o[2];o[0]=f32x16{};o[1]=f32x16{};f32x16 negm=f32x16{};asm volatile("":"+v"(negm));
  const int qrel=wid*QBLK+r32;
  #define CMASK(P0,P1,t) do{int jb_=(t)-(NT-4); if(jb_>=0)cmask(P0,P1,jb_,qrel,hi);}while(0)
  bool resc=false;
  #define START(P0,P1) do{ const float rm=rowmax(P0,P1); resc=false; \
    { const float dl=rm; mhat=fadd_s(mhat,dl); \
      _Pragma("unroll") for(int r=0;r<16;++r){P0[r]=fsub_s(P0[r],dl);P1[r]=fsub_s(P1[r],dl);} \
      _Pragma("unroll") for(int r=0;r<16;++r)negm[r]=-mhat; asm volatile("":"+v"(negm)); } \
    _Pragma("unroll") for(int r=0;r<16;++r)P0[r]=__builtin_amdgcn_exp2f(P0[r]); }while(0)
  #define RESC() do{ if(resc){ asm volatile("s_waitcnt lgkmcnt(0)":::"memory"); \
      _Pragma("unroll") for(int d_=0;d_<2;++d_) _Pragma("unroll") for(int r=0;r<16;++r)o[d_][r]*=wsf[crow(r,hi)]; } }while(0)
  f32x16 pA0,pA1,pB0,pB1;
  int sl_prev=0,sl_cur=0,sl_next=SLOTB;
  #define ROT() do{sl_prev=sl_cur;sl_cur=sl_next;sl_next=(sl_next==(NSLOT-1)*SLOTB)?0:sl_next+SLOTB;}while(0)
  DMA_K(2,2*SLOTB);
  WAIT_BAR(3);
  qkt(pA0,pA1,Kbase,qr,negm,r32,hi);asm volatile("s_nop 15\n\ts_nop 7":"+v"(pA0),"+v"(pA1));CMASK(pA0,pA1,0);
  START(pA0,pA1);
  _Pragma("unroll") for(int r=0;r<16;++r)pA1[r]=__builtin_amdgcn_exp2f(pA1[r]);
  WAIT_BAR(0);
  DMA_K(3,0);DMA_V(1,SLOTB);
  ROT();
  kload8(kf,kp0+sl_cur);
  WAIT_BAR(2);
  s16x4 vlo[8],vhi[8]; u32x4 pw0,pw1,pw2,pw3;
  #define PKW(P,B) cvtpk_s(P[B],P[B+1])
  #define PAF(k) __builtin_bit_cast(bf16x8,pw##k)
  #define VFR(i) (bf16x8){vlo[i][0],vlo[i][1],vlo[i][2],vlo[i][3],vhi[i][0],vhi[i][1],vhi[i][2],vhi[i][3]}
  #define PIN(x) asm volatile("":"+v"(x))
  #define MX3(a,b,c) __builtin_fmaxf(__builtin_fmaxf((a),(b)),(c))
  #define GAPA(MF,A0,A1,A2,A3,W0,W1,PW) do{ MF; sacc+=A0; sacc+=A1; sacc+=A2; sacc+=A3; PIN(sacc); W0; W1; PIN(PW); SBAR(); }while(0)
  #define EX(v) __builtin_amdgcn_exp2f(v)
  #define GAPB(MF,X,B) do{ MF; X[B]=EX(X[B]); X[B+1]=EX(X[B+1]); X[B+2]=EX(X[B+2]); X[B+3]=EX(X[B+3]); PIN(X); SBAR(); }while(0)
  #define VRD(i) do{ vlo[i]=vtr(vp_+(((i)>>2)*4096+((i)&3)*1024)); vhi[i]=vtr(vp_+(((i)>>2)*4096+((i)&3)*1024+512)); }while(0)
  #define KRD(G,j) do{ if(G){ kload2(kf,kp0+sl_next,j); SBAR(); } }while(0)
  #define STEP(C0,C1,P0,P1,t,GK,GV,GL) do{ SBAR(); \
    const lds_cptr vp_=vp0+sl_prev; \
    VRD(0); SBAR(); float sacc=(P0[0]+P0[1]); \
    GAPA(C0=__builtin_amdgcn_mfma_f32_32x32x16_bf16(kf[0],qr[0],negm,0,0,0), P0[2],P0[3],P0[4],P0[5],     pw0[0]=PKW(P0,0), pw0[1]=PKW(P0,2), pw0); \
    VRD(4); SBAR(); GAPA(C1=__builtin_amdgcn_mfma_f32_32x32x16_bf16(kf[1],qr[0],negm,0,0,0), P0[6],P0[7],P0[8],P0[9],     pw0[2]=PKW(P0,4), pw0[3]=PKW(P0,6), pw0); \
    VRD(1); SBAR(); GAPA(C0=__builtin_amdgcn_mfma_f32_32x32x16_bf16(kf[2],qr[1],C0,0,0,0),   P0[10],P0[11],P0[12],P0[13], pw1[0]=PKW(P0,8), pw1[1]=PKW(P0,10), pw1); \
    VRD(5); SBAR(); GAPA(C1=__builtin_amdgcn_mfma_f32_32x32x16_bf16(kf[3],qr[1],C1,0,0,0),   P0[14],P0[15],P1[0],P1[1],   pw1[2]=PKW(P0,12),pw1[3]=PKW(P0,14), pw1); \
    VRD(2); SBAR(); GAPA(C0=__builtin_amdgcn_mfma_f32_32x32x16_bf16(kf[4],qr[2],C0,0,0,0),   P1[2],P1[3],P1[4],P1[5],     pw2[0]=PKW(P1,0), pw2[1]=PKW(P1,2), pw2); \
    VRD(6); SBAR(); GAPA(C1=__builtin_amdgcn_mfma_f32_32x32x16_bf16(kf[5],qr[2],C1,0,0,0),   P1[6],P1[7],P1[8],P1[9],     pw2[2]=PKW(P1,4), pw2[3]=PKW(P1,6), pw2); \
    VRD(3); SBAR(); GAPA(C0=__builtin_amdgcn_mfma_f32_32x32x16_bf16(kf[6],qr[3],C0,0,0,0),   P1[10],P1[11],P1[12],P1[13], pw3[0]=PKW(P1,8), pw3[1]=PKW(P1,10), pw3); \
    VRD(7); SBAR(); GAPA(C1=__builtin_amdgcn_mfma_f32_32x32x16_bf16(kf[7],qr[3],C1,0,0,0),   P1[14],P1[15],0.f,0.f,       pw3[2]=PKW(P1,12),pw3[3]=PKW(P1,14), pw3); \
    l_reg+=sacc; \
    if(GK){DMA_K((t)+3,sl_cur);} if(GV){DMA_V((t)+1,sl_next);} \
    CMASK(C0,C1,t); \
    { float a=MX3(C0[0],C0[1],C1[0]),b=MX3(C0[2],C0[3],C1[1]); a=MX3(a,C1[2],C1[3]); \
      _Pragma("unroll") for(int r=4;r<16;r+=4){a=MX3(a,C0[r],C0[r+1]);b=MX3(b,C0[r+2],C0[r+3]);a=MX3(a,C1[r],C1[r+1]);b=MX3(b,C1[r+2],C1[r+3]);} \
      float rm=__builtin_fmaxf(a,b); { auto rr=__builtin_amdgcn_permlane32_swap(__float_as_uint(rm),__float_as_uint(rm),false,false); rm=__builtin_fmaxf(__uint_as_float(rr[0]),__uint_as_float(rr[1])); } \
      resc=false; \
      if(__builtin_expect(__any(rm>(float)THRL),0)){ const float dl=__builtin_fmaxf(rm,0.f); mhat+=dl; \
        _Pragma("unroll") for(int r=0;r<16;++r){C0[r]-=dl;C1[r]-=dl;} \
        _Pragma("unroll") for(int r=0;r<16;++r)negm[r]=-mhat; asm volatile("":"+v"(negm)); \
        const float f=__builtin_amdgcn_exp2f(-dl); l_reg*=f; if(hi==0)wsf[r32]=f; resc=true; } } \
    SBAR(); \
    GAPB(o[0]=__builtin_amdgcn_mfma_f32_32x32x16_bf16(PAF(0),VFR(0),o[0],0,0,0), C0,0); \
    GAPB(o[1]=__builtin_amdgcn_mfma_f32_32x32x16_bf16(PAF(0),VFR(4),o[1],0,0,0), C0,4); \
    KRD(GL,0); GAPB(o[0]=__builtin_amdgcn_mfma_f32_32x32x16_bf16(PAF(1),VFR(1),o[0],0,0,0), C0,8); \
    KRD(GL,1); GAPB(o[1]=__builtin_amdgcn_mfma_f32_32x32x16_bf16(PAF(1),VFR(5),o[1],0,0,0), C0,12); \
    KRD(GL,2); GAPB(o[0]=__builtin_amdgcn_mfma_f32_32x32x16_bf16(PAF(2),VFR(2),o[0],0,0,0), C1,0); \
    KRD(GL,3); GAPB(o[1]=__builtin_amdgcn_mfma_f32_32x32x16_bf16(PAF(2),VFR(6),o[1],0,0,0), C1,4); \
    GAPB(o[0]=__builtin_amdgcn_mfma_f32_32x32x16_bf16(PAF(3),VFR(3),o[0],0,0,0), C1,8); \
    GAPB(o[1]=__builtin_amdgcn_mfma_f32_32x32x16_bf16(PAF(3),VFR(7),o[1],0,0,0), C1,12); \
    }while(0)
  int t=1;
  #undef CMASK
  #define CMASK(P0,P1,t) do{}while(0)
  for(;t+5<NT;t+=2){
    STEP(pB0,pB1,pA0,pA1,t,true,true,true);     WAIT_BAR(2); RESC(); ROT();
    STEP(pA0,pA1,pB0,pB1,t+1,true,true,true);   WAIT_BAR(2); RESC(); ROT();
  }
  #undef CMASK
  #define CMASK(P0,P1,t) do{int jb_=(t)-(NT-4); if(jb_>=0)cmask(P0,P1,jb_,qrel,hi);}while(0)
  #define ENDW(tt) do{ if((tt)+3<NT){WAIT_BAR(2);} else if((tt)+2<NT){WAIT_BAR(1);} else {WAIT_BAR(0);} }while(0)
  for(;t+1<NT;t+=2){
    STEP(pB0,pB1,pA0,pA1,t,(t+3<NT),(t+1<NT),(t+1<NT));       ENDW(t);   RESC(); ROT();
    STEP(pA0,pA1,pB0,pB1,t+1,(t+4<NT),(t+2<NT),(t+2<NT));     ENDW(t+1); RESC(); ROT();
  }
  STEP(pB0,pB1,pA0,pA1,NT-1,false,false,false); RESC();
  { float sacc=pB0[0]+pB0[1]; _Pragma("unroll") for(int r=2;r<16;++r)sacc+=pB0[r]; _Pragma("unroll") for(int r=0;r<16;++r)sacc+=pB1[r]; l_reg+=sacc;
    pw0=(u32x4){PKW(pB0,0),PKW(pB0,2),PKW(pB0,4),PKW(pB0,6)};pw1=(u32x4){PKW(pB0,8),PKW(pB0,10),PKW(pB0,12),PKW(pB0,14)};pw2=(u32x4){PKW(pB1,0),PKW(pB1,2),PKW(pB1,4),PKW(pB1,6)};pw3=(u32x4){PKW(pB1,8),PKW(pB1,10),PKW(pB1,12),PKW(pB1,14)};
    SBAR(); pv(o,vb0+sl_cur,PAF(0),PAF(1),PAF(2),PAF(3)); }
  #undef PKW
  #undef PAF
  #undef VFR
  #undef PIN
  #undef MX3
  #undef GAPA
  #undef GAPB
  #undef EX
  #undef VRD
  #undef KRD
  #undef STEP
  #undef ENDW
  {auto rr=__builtin_amdgcn_permlane32_swap(__float_as_uint(l_reg),__float_as_uint(l_reg),false,false);l_reg=__uint_as_float(rr[0])+__uint_as_float(rr[1]);}
  if(hi==0)wsf[32+r32]=l_reg;asm volatile("s_waitcnt lgkmcnt(0)":::"memory");
  float rli[16];
  #pragma unroll
  for(int r=0;r<16;++r)rli[r]=__builtin_amdgcn_rcpf(wsf[32+crow(r,hi)]);
  bf16*Ow=Ow0+(long)(wid*QBLK)*OP;
  { bf16*stg=(bf16*)(shm+LDS_OST)+wid*2048;
    #pragma unroll
    for(int r=0;r<16;++r){const int orow=crow(r,hi);
      #pragma unroll
      for(int d0=0;d0<2;++d0)stg[orow*64+d0*32+r32]=(bf16)(cvtpk_s(o[d0][r]*rli[r],0.f)&0xffffu);}
    asm volatile("s_waitcnt lgkmcnt(0)":::"memory");
    #pragma unroll
    for(int i=0;i<4;++i){const int row=i*8+(lane>>3),ch=lane&7; const u32x4 v=*(const u32x4*)(stg+row*64+ch*8); ATTN_STORE16(Ow+(long)row*OP+ch*8,v);} }
  asm volatile("s_waitcnt lgkmcnt(0)\n\ts_barrier":::"memory");
  #undef DMA_K
  #undef DMA_V
  #undef CMASK
  #undef START
  #undef RESC
  #undef ROT
}
#undef SBAR
#undef WAIT_BAR
}
namespace att {
using bf16 = unsigned short;
using bf16x8 = __attribute__((ext_vector_type(8))) short;
using s16x4 = __attribute__((ext_vector_type(4))) short;
using f32x16 = __attribute__((ext_vector_type(16))) float;
using f32x4 = __attribute__((ext_vector_type(4))) float;
using u32x4 = __attribute__((ext_vector_type(4))) unsigned;
constexpr float SCALE = 0.125f, THR = 8.f;
#ifndef A_ONES
#define A_ONES 0
#endif
constexpr bool AONES = A_ONES;
constexpr int LDS_WS = 98304, LDS_STG = 0, STG_WAVE = 8704, LDS_UNIT = 147456 - 64;
#define SBAR() __builtin_amdgcn_sched_barrier(0)
__device__ __forceinline__ int crow(int r, int hi) { return (r & 3) + 8 * (r >> 2) + 4 * hi; }
__device__ __forceinline__ unsigned cvtpk(float lo, float hi) { unsigned r; asm volatile("v_cvt_pk_bf16_f32 %0, %1, %2" : "=v"(r) : "v"(lo), "v"(hi)); return r; }
template <int KW> __device__ __forceinline__ int kswz(int row, int cb) { if constexpr (KW == 64) return row * 128 + (cb ^ (((row >> 1) & 7) << 4)); else return row * 256 + (cb ^ ((row & 15) << 4)); }

template <bool SUB> __device__ __forceinline__ void partialSM(f32x16& p0, float nref) {
#pragma unroll
  for (int r = 0; r < 16; ++r) p0[r] = __builtin_amdgcn_exp2f(SUB ? p0[r] + nref : p0[r]);
}
template <bool SUB, bool SUM> __device__ __forceinline__ void finishSM(f32x16& p0, f32x16& p1, float nref, float& l_reg, bf16x8& pa0, bf16x8& pa1, bf16x8& pa2, bf16x8& pa3) {
#pragma unroll
  for (int r = 0; r < 16; ++r) p1[r] = __builtin_amdgcn_exp2f(SUB ? p1[r] + nref : p1[r]);
  if constexpr (SUM) {
    float ps = 0;
#pragma unroll
    for (int r = 0; r < 16; ++r) ps += p0[r];
#pragma unroll
    for (int r = 0; r < 16; ++r) ps += p1[r];
    l_reg += ps;
  }
#define PK4(P, BASE, OUT) do { unsigned a0 = cvtpk(P[BASE + 0], P[BASE + 1]), a1 = cvtpk(P[BASE + 2], P[BASE + 3]);   \
    unsigned b0 = cvtpk(P[BASE + 4], P[BASE + 5]), b1 = cvtpk(P[BASE + 6], P[BASE + 7]);                              \
    auto r0 = __builtin_amdgcn_permlane32_swap(a0, b0, false, false); auto r1 = __builtin_amdgcn_permlane32_swap(a1, b1, false, false); \
    u32x4 w = {r0[0], r1[0], r0[1], r1[1]}; OUT = *reinterpret_cast<bf16x8*>(&w); } while (0)
  PK4(p0, 0, pa0); PK4(p0, 8, pa1); PK4(p1, 0, pa2); PK4(p1, 8, pa3);
#undef PK4
}
template <int KW, bool CREF> __device__ __forceinline__ void qkt(f32x16& p0, f32x16& p1, const char* Ks, const bf16x8* qr, const f32x16& negm, int r32, int hi, int cboff) {
  if constexpr (!CREF) { p0 = f32x16{}; p1 = f32x16{}; }
#pragma unroll
  for (int d0 = 0; d0 < 4; ++d0) { const int cb = cboff + (d0 * 16 + hi * 8) * 2;
    const bf16x8 b0 = *reinterpret_cast<const bf16x8*>(Ks + kswz<KW>(r32, cb));
    const bf16x8 b1 = *reinterpret_cast<const bf16x8*>(Ks + kswz<KW>(32 + r32, cb));
    if (CREF && d0 == 0) { p0 = __builtin_amdgcn_mfma_f32_32x32x16_bf16(b0, qr[0], negm, 0, 0, 0); p1 = __builtin_amdgcn_mfma_f32_32x32x16_bf16(b1, qr[0], negm, 0, 0, 0); }
    else { p0 = __builtin_amdgcn_mfma_f32_32x32x16_bf16(b0, qr[d0], p0, 0, 0, 0); p1 = __builtin_amdgcn_mfma_f32_32x32x16_bf16(b1, qr[d0], p1, 0, 0, 0); } }
}
template <int NCB> __device__ __forceinline__ int v_st(int k, int c) { const int kk = (k & ~0xC) | ((k & 4) << 1) | ((k & 8) >> 1); return ((kk >> 3) * NCB + (c >> 5)) * 512 + ((kk & 7) * 32 + (c & 31)) * 2; }
__device__ __forceinline__ int v_rd_base(int lane) { return ((lane & 3) << 3) | (((lane >> 2) & 3) << 6) | (((lane >> 4) & 1) << 5) | (((lane >> 5) & 1) << 8); }
template <int NCB> constexpr int v_rd_off(int d0, int ks, int half) { return d0 * 512 + ks * (2 * NCB * 512) + half * (NCB * 512); }
template <int OFF> __device__ __forceinline__ s16x4 tr_read(int vb) { s16x4 r; asm volatile("ds_read_b64_tr_b16 %0, %1 offset:%2" : "=&v"(r) : "v"(vb), "i"(OFF) : "memory"); return r; }
template <int NCB, int D0> __device__ __forceinline__ void pv_one(f32x16& od, int vb, bf16x8 pa0, bf16x8 pa1, bf16x8 pa2, bf16x8 pa3) {
  const s16x4 l0 = tr_read<v_rd_off<NCB>(D0, 0, 0)>(vb), h0 = tr_read<v_rd_off<NCB>(D0, 0, 1)>(vb), l1 = tr_read<v_rd_off<NCB>(D0, 1, 0)>(vb), h1 = tr_read<v_rd_off<NCB>(D0, 1, 1)>(vb);
  const s16x4 l2 = tr_read<v_rd_off<NCB>(D0, 2, 0)>(vb), h2 = tr_read<v_rd_off<NCB>(D0, 2, 1)>(vb), l3 = tr_read<v_rd_off<NCB>(D0, 3, 0)>(vb), h3 = tr_read<v_rd_off<NCB>(D0, 3, 1)>(vb);
  asm volatile("s_waitcnt lgkmcnt(0)" ::: "memory"); SBAR();
#define PK(L, H) (bf16x8){L[0], L[1], L[2], L[3], H[0], H[1], H[2], H[3]}
  od = __builtin_amdgcn_mfma_f32_32x32x16_bf16(pa0, PK(l0, h0), od, 0, 0, 0);
  od = __builtin_amdgcn_mfma_f32_32x32x16_bf16(pa1, PK(l1, h1), od, 0, 0, 0);
  od = __builtin_amdgcn_mfma_f32_32x32x16_bf16(pa2, PK(l2, h2), od, 0, 0, 0);
  od = __builtin_amdgcn_mfma_f32_32x32x16_bf16(pa3, PK(l3, h3), od, 0, 0, 0);
#undef PK
}
template <int NCB> __device__ __forceinline__ void pv_all(f32x16* o, f32x16& lacc, int vb, bf16x8 pa0, bf16x8 pa1, bf16x8 pa2, bf16x8 pa3) {
  pv_one<NCB, 0>(o[0], vb, pa0, pa1, pa2, pa3); pv_one<NCB, 1>(o[1], vb, pa0, pa1, pa2, pa3);
  if constexpr (NCB == 2 && AONES) {
    const bf16x8 ones = {0x3F80, 0x3F80, 0x3F80, 0x3F80, 0x3F80, 0x3F80, 0x3F80, 0x3F80};
    lacc = __builtin_amdgcn_mfma_f32_32x32x16_bf16(pa0, ones, lacc, 0, 0, 0); lacc = __builtin_amdgcn_mfma_f32_32x32x16_bf16(pa1, ones, lacc, 0, 0, 0);
    lacc = __builtin_amdgcn_mfma_f32_32x32x16_bf16(pa2, ones, lacc, 0, 0, 0); lacc = __builtin_amdgcn_mfma_f32_32x32x16_bf16(pa3, ones, lacc, 0, 0, 0);
  }
  if constexpr (NCB == 4) { pv_one<NCB, 2>(o[2], vb, pa0, pa1, pa2, pa3); pv_one<NCB, 3>(o[3], vb, pa0, pa1, pa2, pa3); }
}

struct AttnArgs { const bf16 *QA, *KA, *VA, *QB, *KB, *VB; bf16* mix; const float* gsub; const float* kmax2; };

template <bool ISB> __device__ __forceinline__ void rowmap(int meta, int hidx, int qt, int wid, int i, int& pos, int& hq, bool& valid) {
  if constexpr (!ISB) {
    if (!meta) { pos = 16 + 256 * qt + 32 * wid + i; hq = hidx; valid = true; }
    else { pos = i & 15; hq = 4 * hidx + 2 * (wid & 1) + (i >> 4); valid = wid < 2; }
  } else {
    hq = hidx;
    if (!meta) { pos = 16 + 128 * qt + 32 * (wid >> 1) + i; valid = true; }
    else { pos = i & 15; valid = (wid < 2) && (i < 16); }
  }
}

template <bool ISB>
__device__ __forceinline__ void attn_unit(const AttnArgs& A, int seqbase, int sidx, int L, int hidx, int qt, int meta, char* lds, float lam) {
  constexpr int KW = ISB ? 128 : 64, DV = KW, LDK = ISB ? 512 : 128, NCB = DV / 32;
  constexpr int SHM_K = 64 * KW * 2, SHM_V = 64 * DV * 2;
  constexpr int NCH = KW / 8, RP = 512 / NCH, NP = 64 / RP;
  int tid_ = threadIdx.x; asm volatile("" : "+v"(tid_));
  const int tid = tid_, wid = tid >> 6, lane = tid & 63, r32 = lane & 31, hi = lane >> 5;
  char* V_lds = lds; char* K_lds = lds + 3 * SHM_V;
  float* ws = (float*)(lds + LDS_WS) + wid * 64; float* li_l = ws; float* al_l = ws + 32;
  const int comp = ISB ? (wid & 1) : 0, cboff = comp * 128;
  float l_reg = 0; f32x16 o[NCB]; bf16x8 qr[4]; f32x16 lacc = f32x16{};
#pragma unroll
  for (int d = 0; d < NCB; ++d) o[d] = f32x16{};
  const int kvh = ISB ? hidx : (meta ? hidx : (hidx >> 2));
  const bf16* Kh = (ISB ? A.KB + kvh * 128 : A.KA + kvh * 64) + (size_t)seqbase * LDK;
  const bf16* Vh = (ISB ? A.VB + kvh * 128 : A.VA + kvh * 64) + (size_t)seqbase * LDK;
  const int vb0 = (int)(uintptr_t)V_lds + v_rd_base(lane);
  const int NT = (L + 63) / 64;
  constexpr int NI = SHM_K / 8192;
  const int widu = __builtin_amdgcn_readfirstlane(wid);
  int kofs[NI], vofs[NI];
#pragma unroll
  for (int i = 0; i < NI; ++i) { const int o = (widu * NI + i) * 1024 + lane * 16;
    if constexpr (KW == 128) { const int row = o >> 8, lg = ((o >> 4) & 15) ^ (row & 15); kofs[i] = row * LDK + lg * 8; }
    else { const int row = o >> 7, lg = ((o >> 4) & 7) ^ ((row >> 1) & 7); kofs[i] = row * LDK + lg * 8; }
    { const int sb = o >> 9, g = sb / NCB, cb = sb % NCB, rr = (o >> 6) & 7, cc = (o & 63) >> 1, kk = g * 8 + rr, k = (kk & ~0xC) | ((kk & 4) << 1) | ((kk & 8) >> 1); vofs[i] = k * LDK + cb * 32 + cc; } }
  typedef __attribute__((address_space(3))) unsigned lds_u32;
#define DMA(t, slot) do { const int tt_ = (t) < NT ? (t) : NT - 1; _Pragma("unroll") for (int i_ = 0; i_ < NI; ++i_) { \
    __builtin_amdgcn_global_load_lds((const unsigned*)(Kh + (size_t)tt_ * 64 * LDK + kofs[i_]), (lds_u32*)(K_lds + (slot) * SHM_K + (widu * NI + i_) * 1024), 16, 0, 0); \
    __builtin_amdgcn_global_load_lds((const unsigned*)(Vh + (size_t)tt_ * 64 * LDK + vofs[i_]), (lds_u32*)(V_lds + (slot) * SHM_V + (widu * NI + i_) * 1024), 16, 0, 0); } } while (0)
  f32x16 pA0 = f32x16{}, pA1 = f32x16{}, pB0 = f32x16{}, pB1 = f32x16{}; bf16x8 pa0 = bf16x8{}, pa1 = bf16x8{}, pa2 = bf16x8{}, pa3 = bf16x8{};
  const bool wact = !meta || widu < 2;
  DMA(0, 0); DMA(1, 1); DMA(2, 2);
  { int pos, hq; bool valid; rowmap<ISB>(meta, hidx, qt, wid, r32, pos, hq, valid);
    const bf16* Qw = (ISB ? A.QB + (size_t)(seqbase + pos) * 512 + hq * 128 + comp * 64 : A.QA + (size_t)(seqbase + pos) * 512 + hq * 64) + hi * 8;
#pragma unroll
    for (int d0 = 0; d0 < 4; ++d0) qr[d0] = *reinterpret_cast<const bf16x8*>(Qw + d0 * 16); }
  f32x16 negm; float mref;
  { float qs = 0.f;
#pragma unroll
    for (int d0 = 0; d0 < 4; ++d0)
#pragma unroll
      for (int e = 0; e < 8; ++e) { const float v = __uint_as_float(((unsigned)(unsigned short)qr[d0][e]) << 16); qs = fmaf(v, v, qs); }
    { auto rr = __builtin_amdgcn_permlane32_swap(__float_as_uint(qs), __float_as_uint(qs), false, false); qs = __uint_as_float(rr[0]) + __uint_as_float(rr[1]); }
    const float km2 = A.kmax2[ISB ? 80 + sidx * 8 + hidx * 2 + comp : sidx * 2 + kvh];
    mref = -(sqrtf(qs * km2) * 1.01f);
#pragma unroll
    for (int r = 0; r < 16; ++r) negm[r] = mref; }
  asm volatile("s_waitcnt vmcnt(0)" ::: "memory"); __syncthreads();
  if (wact) { qkt<KW, true>(pA0, pA1, K_lds, qr, negm, r32, hi, cboff); partialSM<false>(pA0, mref); }
  int bprev = 0, bcur = 1, bnext = 2;
#define HALFSTEP(X0, X1, Y0, Y1, LAST) do { \
    SBAR(); if (wact) { qkt<KW, true>(X0, X1, K_lds + bcur * SHM_K, qr, negm, r32, hi, cboff); \
    if (LAST) { asm volatile("" ::: "memory"); _Pragma("unroll") for (int r = 8; r < 16; ++r) X0[r] = -1e30f; _Pragma("unroll") for (int r = 0; r < 16; ++r) X1[r] = -1e30f; } \
    finishSM<false, ISB || !AONES>(Y0, Y1, mref, l_reg, pa0, pa1, pa2, pa3); } SBAR(); \
    if (wact) { pv_all<NCB>(o, lacc, vb0 + bprev * SHM_V, pa0, pa1, pa2, pa3); partialSM<false>(X0, mref); } \
    asm volatile("s_waitcnt vmcnt(0)" ::: "memory"); __syncthreads(); DMA(t + 2, bprev); \
    { const int t_ = bprev; bprev = bcur; bcur = bnext; bnext = t_; } } while (0)
  for (int t = 1; t < NT; t += 2) {
    { HALFSTEP(pB0, pB1, pA0, pA1, false); }
    { const int t0_ = t; const int t = t0_ + 1; HALFSTEP(pA0, pA1, pB0, pB1, __builtin_expect(t + 1 == NT, 0)); }
  }
  if (wact) { finishSM<false, ISB || !AONES>(pA0, pA1, mref, l_reg, pa0, pa1, pa2, pa3); SBAR();
  pv_all<NCB>(o, lacc, vb0 + bprev * SHM_V, pa0, pa1, pa2, pa3); }
  asm volatile("s_waitcnt vmcnt(0)" ::: "memory"); __syncthreads();
  float rli[16];
  if constexpr (ISB || !AONES) {
    { auto rr = __builtin_amdgcn_permlane32_swap(__float_as_uint(l_reg), __float_as_uint(l_reg), false, false); l_reg = __uint_as_float(rr[0]) + __uint_as_float(rr[1]); }
    if (hi == 0) li_l[r32] = l_reg; asm volatile("s_waitcnt lgkmcnt(0)" ::: "memory");
#pragma unroll
    for (int r = 0; r < 16; ++r) rli[r] = __builtin_amdgcn_rcpf(li_l[crow(r, hi)]);
  } else {
#pragma unroll
    for (int r = 0; r < 16; ++r) rli[r] = __builtin_amdgcn_rcpf(lacc[r]);
  }
  const int i2 = lane >> 1, half = lane & 1;
  int pos2, hq2; bool valid2; rowmap<ISB>(meta, hidx, qt, wid, i2, pos2, hq2, valid2);
  if constexpr (!ISB) {
    float* stg = (float*)(lds + LDS_STG + wid * STG_WAVE);
#pragma unroll
    for (int r = 0; r < 16; ++r)
#pragma unroll
      for (int d0 = 0; d0 < 2; ++d0) stg[crow(r, hi) * 68 + d0 * 32 + r32] = o[d0][r] * rli[r];
    asm volatile("s_waitcnt lgkmcnt(0)" ::: "memory");
    bf16* Op = A.mix + (size_t)(seqbase + pos2) * 1024 + hq2 * 64 + half * 32;
#pragma unroll
    for (int c = 0; c < 4; ++c) { const f32x4 a = *(const f32x4*)(stg + i2 * 68 + half * 32 + c * 8), b = *(const f32x4*)(stg + i2 * 68 + half * 32 + c * 8 + 4);
      u32x4 w = {cvtpk(a[0], a[1]), cvtpk(a[2], a[3]), cvtpk(b[0], b[1]), cvtpk(b[2], b[3])}; if (valid2) *(u32x4*)(Op + c * 8) = w; }
  } else {
    float* reg = (float*)(lds + LDS_STG + (wid & ~1) * STG_WAVE);
#pragma unroll
    for (int d = 0; d < 4; ++d)
#pragma unroll
      for (int r = 0; r < 16; ++r) o[d][r] *= rli[r];
    if (comp == 1) {
#pragma unroll
      for (int d = 0; d < 4; ++d)
#pragma unroll
        for (int r = 0; r < 16; ++r) reg[(d * 16 + r) * 64 + lane] = o[d][r];
    }
    __syncthreads();
    if (comp == 0) {
#pragma unroll
      for (int d = 0; d < 4; ++d)
#pragma unroll
        for (int r = 0; r < 16; ++r) o[d][r] -= lam * reg[(d * 16 + r) * 64 + lane];
      asm volatile("s_waitcnt lgkmcnt(0)" ::: "memory");
#pragma unroll
      for (int d = 0; d < 4; ++d)
#pragma unroll
        for (int r = 0; r < 16; ++r) reg[crow(r, hi) * 132 + d * 32 + r32] = o[d][r];
      asm volatile("s_waitcnt lgkmcnt(0)" ::: "memory");
      f32x4 v[16]; float ss = 0.f;
#pragma unroll
      for (int c = 0; c < 16; ++c) { v[c] = *(const f32x4*)(reg + i2 * 132 + half * 64 + c * 4); ss += (v[c][0] * v[c][0] + v[c][1] * v[c][1]) + (v[c][2] * v[c][2] + v[c][3] * v[c][3]); }
      ss += __shfl_xor(ss, 1);
      const float rs = rsqrtf(ss * (1.0f / 128.0f) + NORM_EPS) * 0.8f;
      bf16* Op = A.mix + (size_t)(seqbase + pos2) * 1024 + 512 + hq2 * 128 + half * 64;
      const float* gp = A.gsub + half * 64;
#pragma unroll
      for (int c = 0; c < 8; ++c) { const f32x4 g0 = *(const f32x4*)(gp + c * 8), g1 = *(const f32x4*)(gp + c * 8 + 4); const f32x4 a = v[2 * c] * g0 * rs, b = v[2 * c + 1] * g1 * rs;
        u32x4 w = {cvtpk(a[0], a[1]), cvtpk(a[2], a[3]), cvtpk(b[0], b[1]), cvtpk(b[2], b[3])}; if (valid2) *(u32x4*)(Op + c * 8) = w; }
    }
  }
#undef DMA
#undef HALFSTEP
}
#undef SBAR

constexpr int U1 = 32, U2 = 16, U3 = 1024, U4 = 1024, U5 = 128, U6 = 64, U7 = 2048, U8 = 2048, NUNITS = U1 + U2 + U3 + U4 + U5 + U6 + U7 + U8;
__device__ __forceinline__ void attn_phase(const AttnArgs& A, char* lds, unsigned* counter, float lam) {
  volatile int* s_unit = (volatile int*)(lds + LDS_UNIT);
  for (;;) {
    __syncthreads();
    if (threadIdx.x == 0) *s_unit = (int)atomicAdd(counter, 1u);
    __syncthreads();
    int u = *s_unit;
    if (u >= NUNITS) break;
    int isB, meta, grp, seq, h, qt = 0;
    if (u < U1) { isB = 1; meta = 1; grp = 0; seq = u >> 2; h = u & 3; }
    else if ((u -= U1) < U2) { isB = 0; meta = 1; grp = 0; seq = u >> 1; h = u & 1; }
    else if ((u -= U2) < U3) { isB = 1; meta = 0; grp = 0; seq = u >> 7; h = (u & 127) >> 5; qt = u & 31; }
    else if ((u -= U3) < U4) { isB = 0; meta = 0; grp = 0; seq = u >> 7; h = (u & 127) >> 4; qt = u & 15; }
    else if ((u -= U4) < U5) { isB = 1; meta = 1; grp = 1; seq = u >> 2; h = u & 3; }
    else if ((u -= U5) < U6) { isB = 0; meta = 1; grp = 1; seq = u >> 1; h = u & 1; }
    else if ((u -= U6) < U7) { isB = 1; meta = 0; grp = 1; seq = u >> 6; h = (u & 63) >> 4; qt = u & 15; }
    else { u -= U7; isB = 0; meta = 0; grp = 1; seq = u >> 6; h = (u & 63) >> 3; qt = u & 7; }
    const int seqbase = grp ? ROWS_P + seq * L_S : seq * L_P, L = grp ? L_S : L_P;
    const int sidx = grp ? NSEQ_P + seq : seq;
#if !defined(ONLY_A)
    if (isB) attn_unit<true>(A, seqbase, sidx, L, h, qt, meta, lds, lam);
#endif
#if !defined(ONLY_B)
    if (!isB) {
      if (!meta) {
        const size_t qrow = (size_t)(seqbase + 16 + 256 * qt);
        ab::attn_unit<8>(A.QA + qrow * 512 + h * 64, A.KA + (size_t)seqbase * 128 + (h >> 2) * 64, A.VA + (size_t)seqbase * 128 + (h >> 2) * 64, A.mix + qrow * 1024 + h * 64, (L + 127) / 128 * 2, lds);
      } else attn_unit<false>(A, seqbase, sidx, L, h, qt, meta, lds, lam);
    }
#endif
  }
}
}
constexpr size_t WS_CTL = 0;
constexpr size_t WS_RSS1 = 4096, WS_RSS2 = WS_RSS1 + (size_t)MPAD * 4;
constexpr size_t WS_TAB = 1u << 20;
constexpr size_t TAB_BYTES = (size_t)L_P * 32 * 4;
constexpr size_t WS_W = 4u << 20;
constexpr size_t WS_WIN = WS_W, WS_WO = WS_WIN + (size_t)INC * DM * 2, WS_WG = WS_WO + (size_t)DM * DM * 2, WS_WU = WS_WG + (size_t)FF * DM * 2, WS_WD = WS_WU + (size_t)FF * DM * 2;
constexpr size_t WS_BIG = 28u << 20;
static_assert(WS_WD + (size_t)FF * DM * 2 <= WS_BIG && WS_RSS2 + (size_t)MPAD * 4 <= WS_TAB && WS_TAB + 4 * TAB_BYTES <= WS_W, "ws map");
constexpr size_t WS_HB = WS_BIG;
constexpr size_t WS_ACT = WS_HB + (size_t)MPAD * DM * 2;
constexpr size_t WS_GLO = WS_ACT + (size_t)MPAD * FF * 2;
constexpr size_t WS_END = WS_GLO + (size_t)MPAD * 1280 * 2 + 65536;
constexpr size_t WS_XN = WS_ACT;
constexpr size_t WS_QA = WS_XN + (size_t)MPAD * DM * 2, WS_KA = WS_QA + (size_t)MPAD * 512 * 2, WS_VA = WS_KA + (size_t)MPAD * 128 * 2,
                 WS_QB = WS_VA + (size_t)MPAD * 128 * 2, WS_KB = WS_QB + (size_t)MPAD * 512 * 2, WS_VB = WS_KB + (size_t)MPAD * 512 * 2;
static_assert(WS_VB + (size_t)MPAD * 512 * 2 <= WS_END, "ws map 2");
static_assert((size_t)MPAD * 1536 * 2 <= (size_t)OUT_ROWS * DM * 4, "Ghi fits in d_out");
constexpr int LDS_BYTES = 147456;

#define LAS __attribute__((address_space(3)))
typedef unsigned short bf16;
typedef float f32x4 __attribute__((ext_vector_type(4)));
typedef unsigned v4u __attribute__((ext_vector_type(4)));
typedef unsigned v2u __attribute__((ext_vector_type(2)));
__device__ __forceinline__ unsigned pk2(float lo, float hi) { return pg8::cvt_pk_bf16(lo, hi); }
__device__ __forceinline__ float wave_sum(float v) {
#pragma unroll
    for (int o = 1; o < 64; o <<= 1) v += __shfl_xor(v, o);
    return v;
}
__device__ const double INVB[32] = {1.0, 0.7498942093324559, 0.5623413251903491, 0.4216965034285822, 0.31622776601683794, 0.23713737056616552, 0.1778279410038923, 0.1333521432163324,
    0.1, 0.07498942093324558, 0.05623413251903491, 0.042169650342858224, 0.03162277660168379, 0.023713737056616554, 0.01778279410038923, 0.01333521432163324,
    0.01, 0.007498942093324558, 0.005623413251903491, 0.004216965034285823, 0.0031622776601683794, 0.0023713737056616554, 0.0017782794100389228, 0.001333521432163324,
    0.001, 0.0007498942093324559, 0.0005623413251903491, 0.00042169650342858224, 0.00031622776601683794, 0.00023713737056616554, 0.00017782794100389227, 0.0001333521432163324};
__device__ __forceinline__ void sincos_d(double x, float& s, float& c) {
    const double k = rint(x * 0.6366197723675814);
    double r = fma(-k, 1.5707963267948966, x); r = fma(-k, 6.123233995736766e-17, r);
    const int q = ((int)k) & 3; const double r2 = r * r;
    const double sp = r * (1.0 + r2 * (-1.0 / 6 + r2 * (1.0 / 120 + r2 * (-1.0 / 5040 + r2 * (1.0 / 362880 + r2 * (-1.0 / 39916800 + r2 * (1.0 / 6227020800.0)))))));
    const double cp = 1.0 + r2 * (-0.5 + r2 * (1.0 / 24 + r2 * (-1.0 / 720 + r2 * (1.0 / 40320 + r2 * (-1.0 / 3628800 + r2 * (1.0 / 479001600 + r2 * (-1.0 / 87178291200.0)))))));
    const double ss = (q & 1) ? cp : sp, cc = (q & 1) ? sp : cp;
    s = (float)((q & 2) ? -ss : ss); c = (float)(((q + 1) & 2) ? -cc : cc);
}
__device__ __forceinline__ void transpose_item(const float* W, int K, int N, bf16* WT, const float* gs, bool perm, LAS float* scr, int item, int lane) {
    const int nblk = N / 32, kb = item / nblk, nb = item % nblk, k0 = 64 * kb, n0 = 32 * nb;
#pragma unroll 8
    for (int i = 0; i < 32; ++i) { const int kk = 2 * i + (lane >> 5); float v = W[(size_t)(k0 + kk) * N + n0 + (lane & 31)]; if (gs) v *= gs[k0 + kk]; scr[kk * 33 + (lane & 31)] = v; }
    asm volatile("s_waitcnt lgkmcnt(0)" ::: "memory");
    const int c = lane & 7;
    const int t0 = perm ? ((n0 >> 8) * 256 + ((n0 >> 5) & 1) * 128 + ((n0 >> 6) & 3) * 32) : n0;
#pragma unroll
    for (int j = 0; j < 4; ++j) { const int n = (lane >> 3) + 8 * j; const LAS float* s = scr + (8 * c) * 33 + n;
        v4u o; o.x = pk2(s[0 * 33], s[1 * 33]); o.y = pk2(s[2 * 33], s[3 * 33]); o.z = pk2(s[4 * 33], s[5 * 33]); o.w = pk2(s[6 * 33], s[7 * 33]);
        *(v4u*)(WT + (size_t)(t0 + n) * K + k0 + 8 * c) = o; }
    asm volatile("s_waitcnt lgkmcnt(0)" ::: "memory");
}

#define XB_TMO      128
#define XB_XCNT(j)  (256  + 64 * (j))
#define XB_XSUB(j)  (1280 + 64 * (j))
#define XB_XGEN(j)  (2304 + 64 * (j))
#define XB_TOP      3328
#define XB_TOPGEN   3392
#define XCD_BAR_WORDS 3456
#define XB_SPIN_CAP (1u << 18)

__device__ __forceinline__ unsigned xb_ld(unsigned* p)              { return __hip_atomic_load(p, __ATOMIC_RELAXED, __HIP_MEMORY_SCOPE_AGENT); }
__device__ __forceinline__ unsigned xb_add(unsigned* p, unsigned v) { return __hip_atomic_fetch_add(p, v, __ATOMIC_RELAXED, __HIP_MEMORY_SCOPE_AGENT); }
__device__ __forceinline__ unsigned xb_xcc_id() { return (unsigned)__builtin_amdgcn_s_getreg((3 << 11) | 20) & 0xFu; }
#define XB_SPIN(cond, bar) do { unsigned _sp = 0; while (cond) { __builtin_amdgcn_s_sleep(1); \
    if ((++_sp & 255u) == 0u) { if (xb_ld(&(bar)[XB_TMO])) break; if (_sp > XB_SPIN_CAP) { atomicAdd(&(bar)[XB_TMO], 1u); break; } } } } while (0)

struct XcdBarrier {
    unsigned* bar; unsigned x;
    volatile LAS unsigned* st;
};

__device__ __forceinline__ XcdBarrier xcd_barrier_post(unsigned* bar, volatile LAS unsigned* st) {
    XcdBarrier b; b.bar = bar; b.x = xb_xcc_id(); b.st = st;
    if (threadIdx.x == 0) (void)xb_add(&bar[XB_XCNT(b.x)], 1u);
    return b;
}
__device__ __forceinline__ void xcd_barrier_complete(unsigned* bar, unsigned x, unsigned& nloc, unsigned& nx) {
    const unsigned G = gridDim.x * gridDim.y * gridDim.z;
    unsigned sum, cnt, mine, sp = 0u;
    for (;;) {
        sum = 0u; cnt = 0u; mine = 0u;
#pragma unroll
        for (unsigned j = 0; j < 16; ++j) { const unsigned c = xb_ld(&bar[XB_XCNT(j)]); sum += c; cnt += (c > 0u) ? 1u : 0u; mine = (j == x) ? c : mine; }
        if (sum == G) break;
        __builtin_amdgcn_s_sleep(1);
        if ((++sp & 255u) == 0u) { if (xb_ld(&bar[XB_TMO])) break; if (sp > XB_SPIN_CAP) { atomicAdd(&bar[XB_TMO], 1u); break; } }
    }
    nloc = mine > 0u ? mine : 1u; nx = cnt > 0u ? cnt : 1u;
}

__device__ __forceinline__ void xcd_barrier(const XcdBarrier& b) {
    asm volatile("s_waitcnt vmcnt(0)" ::: "memory");
    __syncthreads();
    if (threadIdx.x == 0) {
        unsigned* bar = b.bar;
        __builtin_amdgcn_s_waitcnt(0);
        unsigned nloc = b.st[0], nx = b.st[1];
        if (nloc == 0u) { xcd_barrier_complete(bar, b.x, nloc, nx); b.st[0] = nloc; b.st[1] = nx; }
        const unsigned old = xb_add(&bar[XB_XSUB(b.x)], 1u);
        const unsigned gen = old / nloc;
        if (old + 1u == (gen + 1u) * nloc) {
            __builtin_amdgcn_fence(__ATOMIC_RELEASE, "agent");
            asm volatile("s_waitcnt vmcnt(0)" ::: "memory");
            const unsigned og = xb_add(&bar[XB_TOP], 1u);
            const unsigned tg = og / nx;
            if (og + 1u == (tg + 1u) * nx) xb_add(&bar[XB_TOPGEN], 1u);
            else XB_SPIN(xb_ld(&bar[XB_TOPGEN]) == tg, bar);
            __builtin_amdgcn_fence(__ATOMIC_ACQUIRE, "agent");
            xb_add(&bar[XB_XGEN(b.x)], 1u);
            asm volatile("s_waitcnt vmcnt(0)" ::: "memory");
        } else {
            XB_SPIN(xb_ld(&bar[XB_XGEN(b.x)]) == gen, bar);
            __builtin_amdgcn_fence(__ATOMIC_ACQUIRE, "agent");
            asm volatile("s_waitcnt vmcnt(0)" ::: "memory");
        }
    }
    __syncthreads();
}

constexpr size_t WS_XBAR = 800u << 10;
static_assert(WS_XBAR >= WS_RSS2 + (size_t)MPAD * 4 && WS_XBAR + XCD_BAR_WORDS * 4 <= WS_TAB, "barrier words");
#ifndef PH_MASK
#define PH_MASK 0xff
#endif
struct Args { const float* in[20]; float* out; unsigned char* ws; };

__global__ void __launch_bounds__(512, 2) mega_fwd(Args a) {
    extern __shared__ __attribute__((aligned(16))) unsigned char lds[];
    cg::grid_group grid = cg::this_grid();
    volatile LAS unsigned* xb_st = (volatile LAS unsigned*)((LAS unsigned char*)lds + (LDS_BYTES - 128));
    if (threadIdx.x < 2) xb_st[threadIdx.x] = 0u;
    __syncthreads();
#define TID_DEFS const int tid = threadIdx.x, lane = tid & 63, wave = __builtin_amdgcn_readfirstlane(tid >> 6); const int G = gridDim.x, gw = blockIdx.x * 8 + wave, NGW = G * 8; (void)lane; (void)gw; (void)NGW; (void)G
#define WSP(T, off) ((T*)(a.ws + (off)))
#define Win_t WSP(bf16, WS_WIN)
#define Wo_t WSP(bf16, WS_WO)
#define Wg_t WSP(bf16, WS_WG)
#define Wu_t WSP(bf16, WS_WU)
#define Wd_t WSP(bf16, WS_WD)
#define XN WSP(bf16, WS_XN)
#define MIX WSP(bf16, WS_XN)
#define HB WSP(bf16, WS_HB)
#define ACT WSP(bf16, WS_ACT)
#define GLO WSP(bf16, WS_GLO)
#define GHI ((bf16*)a.out)
#define QA WSP(bf16, WS_QA)
#define KA WSP(bf16, WS_KA)
#define VA WSP(bf16, WS_VA)
#define QB WSP(bf16, WS_QB)
#define KB WSP(bf16, WS_KB)
#define VB WSP(bf16, WS_VB)
#define cosA WSP(float, WS_TAB)
#define sinA WSP(float, WS_TAB + TAB_BYTES)
#define cosB WSP(float, WS_TAB + 2 * TAB_BYTES)
#define sinB WSP(float, WS_TAB + 3 * TAB_BYTES)
#define rss1 WSP(float, WS_RSS1)
#define rss2 WSP(float, WS_RSS2)
#define ctl WSP(unsigned, WS_CTL)
#define KMAX2 WSP(float, WS_CTL + 2048)

#if PH_MASK & (1 << 0)
    {
        TID_DEFS;
        LAS float* scr = (LAS float*)((LAS unsigned char*)lds + wave * 16384);
        constexpr int I_IN = (DM / 64) * (INC / 32), I_O = (DM / 64) * (DM / 32), I_G = (DM / 64) * (FF / 32), I_D = (FF / 64) * (DM / 32);
        constexpr int NITEMS = I_IN + I_O + 2 * I_G + I_D;
        for (int it = gw; it < NITEMS; it += NGW) {
            int r = it;
            if (r < I_IN) { transpose_item(a.in[4], DM, INC, Win_t, nullptr, true, scr, r, lane); continue; } r -= I_IN;
            if (r < I_O) { transpose_item(a.in[12], DM, DM, Wo_t, nullptr, false, scr, r, lane); continue; } r -= I_O;
            if (r < I_G) { transpose_item(a.in[14], DM, FF, Wg_t, a.in[13], false, scr, r, lane); continue; } r -= I_G;
            if (r < I_G) { transpose_item(a.in[15], DM, FF, Wu_t, a.in[13], false, scr, r, lane); continue; } r -= I_G;
            transpose_item(a.in[18], FF, DM, Wd_t, nullptr, false, scr, r, lane);
        }
        const f32x4* gm = (const f32x4*)a.in[3] + lane;
        const f32x4 g0 = gm[0], g1 = gm[64], g2 = gm[128], g3 = gm[192];
        static_assert(MPAD % 4 == 0, "four rows per wave trip");
        for (int m0 = gw * 4; m0 < MPAD; m0 += NGW * 4) {
            f32x4 v[4][4];
#pragma unroll
            for (int r = 0; r < 4; ++r) {
                const int m = m0 + r < MROWS ? m0 + r : 0;
                const RowInfo ri = rowinfo(m);
                const float* hp = ri.pos < 16 ? a.in[2] + (size_t)ri.pos * DM : (ri.grp ? a.in[1] : a.in[0]) + (size_t)ri.xrow * DM;
                const f32x4* xr = (const f32x4*)hp + lane;
#pragma unroll
                for (int j = 0; j < 4; ++j) v[r][j] = xr[64 * j];
            }
#pragma unroll
            for (int r = 0; r < 4; ++r) {
                float s2 = 0.f;
#pragma unroll
                for (int j = 0; j < 4; ++j) s2 += (v[r][j].x * v[r][j].x + v[r][j].y * v[r][j].y) + (v[r][j].z * v[r][j].z + v[r][j].w * v[r][j].w);
                const float rstd = (m0 + r < MROWS) ? rsqrtf(wave_sum(s2) * (1.f / DM) + NORM_EPS) : 0.f;
                unsigned long long* o8 = (unsigned long long*)(XN + (size_t)(m0 + r) * DM) + lane;
                const f32x4 y0 = v[r][0] * g0 * rstd, y1 = v[r][1] * g1 * rstd, y2 = v[r][2] * g2 * rstd, y3 = v[r][3] * g3 * rstd;
                o8[0] = (unsigned long long)pk2(y0.x, y0.y) | ((unsigned long long)pk2(y0.z, y0.w) << 32);
                o8[64] = (unsigned long long)pk2(y1.x, y1.y) | ((unsigned long long)pk2(y1.z, y1.w) << 32);
                o8[128] = (unsigned long long)pk2(y2.x, y2.y) | ((unsigned long long)pk2(y2.z, y2.w) << 32);
                o8[192] = (unsigned long long)pk2(y3.x, y3.y) | ((unsigned long long)pk2(y3.z, y3.w) << 32);
            }
        }
        const int gt = blockIdx.x * 512 + tid, NGT = G * 512;
        for (int e = gt; e < L_P * 32; e += NGT) {
            const int pos = e >> 5, i = e & 31;
            float s, c;
            sincos_d((double)pos * INVB[i], s, c); cosB[e] = c; sinB[e] = s;
            if (pos < 16) { cosA[e] = 1.f; sinA[e] = 0.f; }
            else { const int t = pos - 16; const int rc = i < 16 ? (t >> 6) : (t & 63); sincos_d((double)rc * INVB[2 * (i & 15)], s, c); cosA[e] = c; sinA[e] = s; }
        }
        for (int e = gt; e < 2 * MPAD; e += NGT) rss1[e] = 0.f;
        if (gt == 0) ctl[0] = 0u;
        if (gt < 400) KMAX2[gt] = 0.f;
        for (int e = gt; e < XCD_BAR_WORDS; e += NGT) WSP(unsigned, WS_XBAR)[e] = 0u;
    }
#endif
    grid.sync();
    const XcdBarrier xb = xcd_barrier_post(WSP(unsigned, WS_XBAR), xb_st);

#if PH_MASK & (1 << 1)
    {
        TID_DEFS;
        pg8::Gemm g{XN, Win_t, MPAD, INC, DM}; pg8::StaticOrder S; S.init(MPAD, INC, G, (int)blockIdx.x);
        pg8::EpiQKV E{QA, KA, VA, QB, KB, VB, cosA, sinA, cosB, sinB, a.in[5], a.in[6], KMAX2};
#if defined(DUP_P1)
        int nrep = 2; asm volatile("" : "+s"(nrep));
        for (int rep = 0; rep < nrep; ++rep)
#endif
        pg8::gemm_phase<pg8::EpiQKV, pg8::StaticOrder, true, true>((LAS unsigned char*)lds, g, S, E);
    }
#endif
    xcd_barrier(xb);

#if PH_MASK & (1 << 2)
    {
        TID_DEFS;
        const float s1 = wave_sum(a.in[7][lane] * a.in[8][lane]), s2 = wave_sum(a.in[9][lane] * a.in[10][lane]);
        const float lam = __expf(s1) - __expf(s2) + 0.2f;
        const att::AttnArgs A{QA, KA, VA, QB, KB, VB, MIX, a.in[11], KMAX2};
        att::attn_phase(A, (char*)lds, ctl, lam);
    }
#endif
    xcd_barrier(xb);

#if PH_MASK & (1 << 3)
    {
        TID_DEFS;
        pg8::Gemm g{MIX, Wo_t, MPAD, DM, DM}; pg8::StaticOrder S; S.init(MPAD, DM, G, (int)blockIdx.x);
        pg8::EpiWo E{a.in[0], a.in[1], a.in[2], HB, rss1};
        pg8::gemm_phase<pg8::EpiWo, pg8::StaticOrder, true, true>((LAS unsigned char*)lds, g, S, E);
    }
#endif
    xcd_barrier(xb);

#if PH_MASK & (1 << 4)
    {
        TID_DEFS;
        pg8::Gemm g{HB, Wg_t, MPAD, FF, DM}; pg8::StaticOrder S; S.init(MPAD, FF, G, (int)blockIdx.x);
        pg8::EpiGate E{GLO, GHI, rss1};
#if defined(DUP_P4)
        int nrep = 2; asm volatile("" : "+s"(nrep));
        for (int rep = 0; rep < nrep; ++rep)
#endif
        pg8::gemm_phase<pg8::EpiGate, pg8::StaticOrder, true, true>((LAS unsigned char*)lds, g, S, E);
    }
#endif
    xcd_barrier(xb);

#if PH_MASK & (1 << 5)
    {
        TID_DEFS;
        pg8::Gemm g{HB, Wu_t, MPAD, FF, DM}; pg8::StaticOrder S; S.init(MPAD, FF, G, (int)blockIdx.x);
        pg8::EpiUp E{GLO, GHI, rss1, a.in[16], a.in[17], ACT};
#if defined(DUP_P5)
        int nrep = 2; asm volatile("" : "+s"(nrep));
        for (int rep = 0; rep < nrep; ++rep)
#endif
        pg8::gemm_phase<pg8::EpiUp, pg8::StaticOrder, true, true>((LAS unsigned char*)lds, g, S, E);
    }
#endif
    xcd_barrier(xb);

#if PH_MASK & (1 << 6)
    {
        TID_DEFS;
        pg8::Gemm g{ACT, Wd_t, MPAD, DM, FF}; pg8::StaticOrder S; S.init(MPAD, DM, G, (int)blockIdx.x);
        pg8::EpiDown E{HB, a.out, rss2};
        pg8::gemm_phase<pg8::EpiDown, pg8::StaticOrder, true, true>((LAS unsigned char*)lds, g, S, E);
    }
#endif
    xcd_barrier(xb);

#if PH_MASK & (1 << 7)
    {
        TID_DEFS;
        const f32x4* gf = (const f32x4*)a.in[19] + lane;
        const f32x4 g0 = gf[0], g1 = gf[64], g2 = gf[128], g3 = gf[192];
        static_assert(OUT_ROWS % 4 == 0, "four rows per wave trip");
        for (int m0 = gw * 4; m0 < OUT_ROWS; m0 += NGW * 4) {
            f32x4 v[4][4]; float rs[4];
#pragma unroll
            for (int r = 0; r < 4; ++r) { const f32x4* xr = (const f32x4*)(a.out + (size_t)(m0 + r) * DM) + lane; rs[r] = rss2[m0 + r];
#pragma unroll
                for (int j = 0; j < 4; ++j) v[r][j] = xr[64 * j]; }
#pragma unroll
            for (int r = 0; r < 4; ++r) { f32x4* xr = (f32x4*)(a.out + (size_t)(m0 + r) * DM) + lane; const float rstd = rsqrtf(rs[r] * (1.f / DM) + NORM_EPS);
                xr[0] = v[r][0] * g0 * rstd; xr[64] = v[r][1] * g1 * rstd; xr[128] = v[r][2] * g2 * rstd; xr[192] = v[r][3] * g3 * rstd; }
        }
    }
#endif
}

extern "C" void kernel_launch(void* const* d_in, const int* in_sizes, int n_in, void* d_out, int out_size, void* d_ws, size_t ws_size, hipStream_t stream) {
    static int grid = 0;
    if (grid == 0) {
        if (n_in != 20 || out_size != OUT_ROWS * DM || ws_size < WS_END) { fprintf(stderr, "kernel_launch: unexpected shapes n_in %d out %d ws %zu (need %zu)\n", n_in, out_size, ws_size, (size_t)WS_END); grid = -1; return; }
        int dev = 0, cus = 0, per_cu = 0;
        hipGetDevice(&dev); hipDeviceGetAttribute(&cus, hipDeviceAttributeMultiprocessorCount, dev);
        hipFuncSetAttribute((const void*)mega_fwd, hipFuncAttributeMaxDynamicSharedMemorySize, LDS_BYTES);
        hipOccupancyMaxActiveBlocksPerMultiprocessor(&per_cu, (const void*)mega_fwd, 512, LDS_BYTES);
        if (per_cu < 1) { fprintf(stderr, "kernel_launch: occupancy query says %d blocks/CU\n", per_cu); per_cu = 1; }
        (void)hipGetLastError();
        grid = cus * 1;
    }
    if (grid < 0) return;
    Args a{};
    for (int i = 0; i < 20; ++i) a.in[i] = (const float*)d_in[i];
    a.out = (float*)d_out; a.ws = (unsigned char*)d_ws;
    void* args[] = {&a};
    hipError_t e = hipLaunchCooperativeKernel((const void*)mega_fwd, dim3(grid), dim3(512), args, LDS_BYTES, stream);
    if (e != hipSuccess) fprintf(stderr, "cooperative launch failed: %s (grid %d)\n", hipGetErrorString(e), grid);
}
```

```cpp
#include <hip/hip_runtime.h>
#include <hip/hip_bf16.h>
#include <hip/hip_cooperative_groups.h>
#include <cstdio>
#include <cstdint>
#include <cmath>
namespace cg = cooperative_groups;

constexpr int DM = 1024, FF = 2816, INC = 2304;
constexpr int NSEQ_P = 8, S_P = 4096, L_P = 4112, NSEQ_S = 32, S_S = 2048, L_S = 2064;
constexpr int ROWS_P = NSEQ_P * L_P;
constexpr int ROWS_S = NSEQ_S * L_S;
constexpr int MROWS = ROWS_P + ROWS_S;
constexpr int MPAD = 99072;
constexpr int OUT_ROWS_P = NSEQ_P * S_P;
constexpr int OUT_ROWS = OUT_ROWS_P + NSEQ_S * S_S;
constexpr float NORM_EPS = 1e-6f;
static_assert(MPAD % 256 == 0 && MPAD >= MROWS + 64, "pad");
static_assert(L_P % 64 == 16 && L_S % 64 == 16, "tail tile holds 16 keys");

struct RowInfo { int pos, L, xrow, grp, sidx; };
__device__ __forceinline__ RowInfo rowinfo(int row) {
    RowInfo r;
    if (row < ROWS_P) { const int s = row / L_P; r.pos = row - s * L_P; r.L = L_P; r.grp = 0; r.sidx = s; r.xrow = s * S_P + r.pos - 16; }
    else { const int q = row - ROWS_P; const int s = q / L_S; r.pos = q - s * L_S; r.L = L_S; r.grp = 1; r.sidx = NSEQ_P + s; r.xrow = s * S_S + r.pos - 16; }
    return r;
}
namespace pg8 {
#define PG8_LAS __attribute__((address_space(3)))
typedef unsigned short bf16_t;
typedef short bf16x8 __attribute__((ext_vector_type(8)));
typedef float f32x4 __attribute__((ext_vector_type(4)));
typedef unsigned u32x4 __attribute__((ext_vector_type(4)));
constexpr int BM = 256, BK = 64, HALF = 128, HTB = HALF * BK * 2  , STAGE_BYTES = 8 * HTB, NXCD = 8, WGM = 4;

__host__ __device__ __forceinline__ int lds_byte(int r, int c) { const int st = (r >> 4) * 2 + (c >> 5), rr = r & 15, cc = c & 31, ob = rr * 64 + cc * 2; return st * 1024 + (ob ^ (((ob >> 9) & 1) << 5)); }
__host__ __device__ __forceinline__ void stage_rc(int b, int& R, int& C) { const int st = b / 1024, sb = b % 1024, swz = sb ^ (((sb >> 9) & 1) << 5); R = (st >> 1) * 16 + swz / 64; C = (st & 1) * 32 + (swz % 64) / 2; }
__host__ __device__ __forceinline__ int perm32(int rho) { const int n = rho >> 4, i = rho & 15; return 8 * (i >> 2) + 4 * n + (i & 3); }

struct Unit { int pm, pn; };
struct Gemm { const bf16_t* A; const bf16_t* Bt; int M, N, K; };

struct StaticOrder {
    int nM, nN, nwg, G, c;
    __host__ __device__ void init(int M, int N, int G_, int c_) { nM = M / BM; nN = N / BM; nwg = nM * nN; G = G_; c = c_; }
    __host__ __device__ bool next(int i, Unit& u) const {
        const long L = (long)i * G + c; if (L >= nwg) return false;
        int wgid = (int)L; { const int q = nwg / NXCD, r = nwg % NXCD, xcd = wgid % NXCD, off = wgid / NXCD; wgid = (xcd < r ? xcd * (q + 1) : r * (q + 1) + (xcd - r) * q) + off; }
        const int nig = WGM * nN, gid = wgid / nig, fm = gid * WGM, gsz = (nM - fm) < WGM ? (nM - fm) : WGM;
        u.pm = fm + ((wgid % nig) % gsz); u.pn = (wgid % nig) / gsz; return true;
    }
    __device__ __forceinline__ void a_ready(const Unit&) const {}
    __device__ __forceinline__ void done(const Unit&) const {}
};

__device__ __forceinline__ unsigned cvt_pk_bf16(float lo, float hi) { unsigned r; asm volatile("v_cvt_pk_bf16_f32 %0, %1, %2" : "=v"(r) : "v"(lo), "v"(hi)); return r; }
typedef float f32x2 __attribute__((ext_vector_type(2)));
__device__ __forceinline__ f32x2 gelu_pk(f32x2 v) {
    const f32x2 av = __builtin_elementwise_abs(v), d = av * 0.2316418882f + 1.0f;
    f32x2 t; t.x = __builtin_amdgcn_rcpf(d.x); t.y = __builtin_amdgcn_rcpf(d.y);
    f32x2 q = t * 0.5307027145f + (-0.7265760135f); q = q * t + 0.7107068705f; q = q * t + (-0.142248368f); q = q * t + 0.127414796f; q = q * t;
    const f32x2 s = (v * v) * (-0.72134752044f);
    f32x2 e; e.x = __builtin_amdgcn_exp2f(s.x); e.y = __builtin_amdgcn_exp2f(s.y);
    const f32x2 m = v * (q * e), r = v - m;
    f32x2 o; o.x = v.x < 0.f ? m.x : r.x; o.y = v.y < 0.f ? m.y : r.y; return o;
}
__device__ __forceinline__ u32x4 pack8(const f32x4 a, const f32x4 b) { u32x4 w; w.x = cvt_pk_bf16(a[0], a[1]); w.y = cvt_pk_bf16(a[2], a[3]); w.z = cvt_pk_bf16(b[0], b[1]); w.w = cvt_pk_bf16(b[2], b[3]); return w; }
__device__ __forceinline__ float bflo(unsigned w) { return __uint_as_float(w << 16); }
__device__ __forceinline__ float bfhi(unsigned w) { return __uint_as_float(w & 0xffff0000u); }
__device__ __forceinline__ float dot4(const f32x4 a) { return (a[0] * a[0] + a[1] * a[1]) + (a[2] * a[2] + a[3] * a[3]); }

struct EpiQKV {
    static constexpr bool PERM = true, AFTER_DRAIN = false;
    bf16_t *QA, *KA, *VA, *QB, *KB, *VB; const float *cosA, *sinA, *cosB, *sinB, *gq, *gk; float* kmax2;
    __device__ __forceinline__ void operator()(const f32x4 (&acc)[2][2][4][2], const Unit& u, int wr, int wc, int fr, int fq) const {
        const int g = u.pn * 4 + wc;
        bf16_t* dst; int ldc, col; const float* gn = nullptr; const float* ct = nullptr; const float* st = nullptr;
        float qsc = 1.f; int kst = -1, kmul = 0;
        if (g < 8) { dst = QA; ldc = 512; col = 64 * g; gn = gq; ct = cosA; st = sinA; qsc = 0.125f * 1.4426950408889634f; }
        else if (g < 10) { dst = KA; ldc = 128; col = 64 * (g - 8); gn = gk; ct = cosA; st = sinA; kst = g - 8; kmul = 2; }
        else if (g < 12) { dst = VA; ldc = 128; col = 64 * (g - 10); }
        else if (g < 20) { dst = QB; ldc = 512; col = 64 * (g - 12); ct = cosB; st = sinB; qsc = 0.125f * 1.4426950408889634f; }
        else if (g < 28) { dst = KB; ldc = 512; col = 64 * (g - 20); ct = cosB; st = sinB; kst = 80 + (g - 20); kmul = 8; }
        else { dst = VB; ldc = 512; col = 64 * (g - 28); }
        f32x4 gv[2][2];
#pragma unroll
        for (int bj = 0; bj < 2; ++bj)
#pragma unroll
            for (int n = 0; n < 2; ++n) gv[bj][n] = gn ? *(const f32x4*)(gn + 32 * bj + 8 * fq + 4 * n) : (f32x4){1.f, 1.f, 1.f, 1.f};
#pragma unroll
        for (int ai = 0; ai < 2; ++ai)
#pragma unroll
            for (int m = 0; m < 4; ++m) {
                const int row = u.pm * BM + ai * HALF + wr * 64 + m * 16 + fr;
                f32x4 a0 = acc[ai][0][m][0], a1 = acc[ai][0][m][1], b0 = acc[ai][1][m][0], b1 = acc[ai][1][m][1];
                if (gn) {
                    float ss = (dot4(a0) + dot4(a1)) + (dot4(b0) + dot4(b1));
                    ss += __shfl_xor(ss, 16); ss += __shfl_xor(ss, 32);
                    const float r = rsqrtf(ss * (1.0f / 64.0f) + NORM_EPS);
                    a0 = a0 * r * gv[0][0]; a1 = a1 * r * gv[0][1]; b0 = b0 * r * gv[1][0]; b1 = b1 * r * gv[1][1];
                }
                if (ct) {
                    const RowInfo ri = rowinfo(row);
                    const float* cp = ct + ri.pos * 32 + 8 * fq; const float* sp = st + ri.pos * 32 + 8 * fq;
                    const f32x4 c0 = *(const f32x4*)cp, c1 = *(const f32x4*)(cp + 4), s0 = *(const f32x4*)sp, s1 = *(const f32x4*)(sp + 4);
                    const f32x4 y0 = a0 * c0 - b0 * s0, y1 = a1 * c1 - b1 * s1, z0 = b0 * c0 + a0 * s0, z1 = b1 * c1 + a1 * s1;
                    a0 = y0; a1 = y1; b0 = z0; b1 = z1;
                }
                a0 = a0 * qsc; a1 = a1 * qsc; b0 = b0 * qsc; b1 = b1 * qsc;
                if (kst >= 0) {
                    float kk = (dot4(a0) + dot4(a1)) + (dot4(b0) + dot4(b1));
                    kk += __shfl_xor(kk, 16); kk += __shfl_xor(kk, 32);
                    const RowInfo rk = rowinfo(row);
                    float* km = kmax2 + kst + kmul * rk.sidx;
                    if (fq == 0 && row < MROWS && kk > *km) atomicMax((unsigned*)km, __float_as_uint(kk));
                }
                bf16_t* p = dst + (size_t)row * ldc + col + 8 * fq;
                *(u32x4*)p = pack8(a0, a1); *(u32x4*)(p + 32) = pack8(b0, b1);
                asm volatile("" ::: "memory");
            }
    }
};

struct EpiWo {
    static constexpr bool PERM = true, AFTER_DRAIN = false;
    const float *xp, *xs, *meta; bf16_t* hb; float* rowss;
    __device__ __forceinline__ void operator()(const f32x4 (&acc)[2][2][4][2], const Unit& u, int wr, int wc, int fr, int fq) const {
        const int col0 = u.pn * BM + wc * 32 + 8 * fq;
#pragma unroll
        for (int ai = 0; ai < 2; ++ai)
#pragma unroll
            for (int m = 0; m < 4; ++m) {
                const int row = u.pm * BM + ai * HALF + wr * 64 + m * 16 + fr;
                const bool live = row < MROWS;
                const RowInfo ri = rowinfo(row);
                const float* hx = ri.grp ? xs : xp; asm volatile("" : "+v"(hx)); const float* hm = meta; asm volatile("" : "+v"(hm));
                const float* hp = ri.pos < 16 ? hm + (size_t)ri.pos * DM : hx + (size_t)ri.xrow * DM;
                float ss = 0.f;
#pragma unroll
                for (int bj = 0; bj < 2; ++bj) {
                    f32x4 v0 = acc[ai][bj][m][0], v1 = acc[ai][bj][m][1];
                    if (live) { v0 = v0 + *(const f32x4*)(hp + col0 + bj * HALF); v1 = v1 + *(const f32x4*)(hp + col0 + bj * HALF + 4); }
                    ss += dot4(v0) + dot4(v1);
                    *(u32x4*)(hb + (size_t)row * DM + col0 + bj * HALF) = pack8(v0, v1);
                }
                ss += __shfl_xor(ss, 16); ss += __shfl_xor(ss, 32);
                if (fq == 0 && live) atomicAdd(rowss + row, ss);
                asm volatile("" ::: "memory");
            }
    }
};

constexpr int GLO_LD = 1280, GHI_LD = 1536, GSPLIT = 5;
struct EpiGate {
    static constexpr bool PERM = true, AFTER_DRAIN = false;
    bf16_t *Glo, *Ghi; const float* rowss;
    __device__ __forceinline__ void operator()(const f32x4 (&acc)[2][2][4][2], const Unit& u, int wr, int wc, int fr, int fq) const {
        bf16_t* base; int ld, colt;
        if (u.pn < GSPLIT) { base = Glo; ld = GLO_LD; colt = u.pn * BM; } else { base = Ghi; ld = GHI_LD; colt = (u.pn - GSPLIT) * BM; }
        const int col0 = colt + wc * 32 + 8 * fq;
#pragma unroll
        for (int ai = 0; ai < 2; ++ai)
#pragma unroll
            for (int m = 0; m < 4; ++m) {
                const int row = u.pm * BM + ai * HALF + wr * 64 + m * 16 + fr;
                const float rs = rsqrtf(rowss[row] * (1.0f / DM) + NORM_EPS);
#pragma unroll
                for (int bj = 0; bj < 2; ++bj)
                    *(u32x4*)(base + (size_t)row * ld + col0 + bj * HALF) = pack8(acc[ai][bj][m][0] * rs, acc[ai][bj][m][1] * rs);
            }
    }
};

__device__ __forceinline__ void unpk8(const u32x4 g, f32x4& lo, f32x4& hi) {
    lo[0] = bflo(g.x); lo[1] = bfhi(g.x); lo[2] = bflo(g.y); lo[3] = bfhi(g.y); hi[0] = bflo(g.z); hi[1] = bfhi(g.z); hi[2] = bflo(g.w); hi[3] = bfhi(g.w);
}
struct EpiUp {
    static constexpr bool PERM = true, AFTER_DRAIN = false;
    const bf16_t *Glo, *Ghi; const float* rowss; const float *cw, *cb; bf16_t* act;
    __device__ __forceinline__ void operator()(const f32x4 (&acc)[2][2][4][2], const Unit& u, int wr, int wc, int fr, int fq) const {
        const bf16_t* base; int ld, colt;
        if (u.pn < GSPLIT) { base = Glo; ld = GLO_LD; colt = u.pn * BM; } else { base = Ghi; ld = GHI_LD; colt = (u.pn - GSPLIT) * BM; }
        const int gcol0 = colt + wc * 32 + 8 * fq, col0 = u.pn * BM + wc * 32 + 8 * fq;
#pragma unroll
        for (int ai = 0; ai < 2; ++ai)
#pragma unroll
            for (int m = 0; m < 4; ++m) {
                const int row = u.pm * BM + ai * HALF + wr * 64 + m * 16 + fr;
                const RowInfo ri = rowinfo(row);
                const bool hp = ri.pos > 0, hn = ri.pos < ri.L - 1;
                const float fp = hp ? 1.f : 0.f, fn = hn ? 1.f : 0.f;
                const float rs = rsqrtf(rowss[row] * (1.0f / DM) + NORM_EPS);
                const bf16_t* gp0 = base + (size_t)row * ld + gcol0;
                const int dm = hp ? -ld : 0, dx = hn ? ld : 0;
#pragma unroll
                for (int bj = 0; bj < 2; ++bj) {
                    const bf16_t* gp = gp0 + bj * HALF;
                    const u32x4 gc = *(const u32x4*)gp, gm = *(const u32x4*)(gp + dm), gx = *(const u32x4*)(gp + dx);
                    const float* wp = cw + col0 + bj * HALF;
                    f32x4 c0, c1, p0, p1, n0, n1; unpk8(gc, c0, c1); unpk8(gm, p0, p1); unpk8(gx, n0, n1);
                    f32x4 t0 = *(const f32x4*)(cb + col0 + bj * HALF) + *(const f32x4*)(wp + FF) * c0 + (*(const f32x4*)wp * p0) * fp + (*(const f32x4*)(wp + 2 * FF) * n0) * fn;
                    f32x4 t1 = *(const f32x4*)(cb + col0 + bj * HALF + 4) + *(const f32x4*)(wp + FF + 4) * c1 + (*(const f32x4*)(wp + 4) * p1) * fp + (*(const f32x4*)(wp + 2 * FF + 4) * n1) * fn;
                    const f32x2 ga = gelu_pk((f32x2){t0[0], t0[1]}), gb = gelu_pk((f32x2){t0[2], t0[3]}), gc2 = gelu_pk((f32x2){t1[0], t1[1]}), gd = gelu_pk((f32x2){t1[2], t1[3]});
                    const f32x4 u0 = acc[ai][bj][m][0] * rs, u1 = acc[ai][bj][m][1] * rs;
                    const f32x4 r0 = (f32x4){ga.x, ga.y, gb.x, gb.y} * u0, r1 = (f32x4){gc2.x, gc2.y, gd.x, gd.y} * u1;
                    *(u32x4*)(act + (size_t)row * FF + col0 + bj * HALF) = pack8(r0, r1);
                    asm volatile("" ::: "memory");
                }
            }
    }
};

struct EpiDown {
    static constexpr bool PERM = true, AFTER_DRAIN = false;
    const bf16_t* hb; float* out; float* rowss2;
    __device__ __forceinline__ void operator()(const f32x4 (&acc)[2][2][4][2], const Unit& u, int wr, int wc, int fr, int fq) const {
        const int col0 = u.pn * BM + wc * 32 + 8 * fq;
#pragma unroll
        for (int ai = 0; ai < 2; ++ai)
#pragma unroll
            for (int m = 0; m < 4; ++m) {
                const int row = u.pm * BM + ai * HALF + wr * 64 + m * 16 + fr;
                const RowInfo ri = rowinfo(row);
                const bool live = row < MROWS && ri.pos >= 16;
                const int orow = (ri.grp ? OUT_ROWS_P : 0) + ri.xrow;
                float ss = 0.f;
#pragma unroll
                for (int bj = 0; bj < 2; ++bj) {
                    if (live) {
                        const u32x4 h = *(const u32x4*)(hb + (size_t)row * DM + col0 + bj * HALF);
                        f32x4 v0 = acc[ai][bj][m][0], v1 = acc[ai][bj][m][1];
                        v0[0] += bflo(h.x); v0[1] += bfhi(h.x); v0[2] += bflo(h.y); v0[3] += bfhi(h.y); v1[0] += bflo(h.z); v1[1] += bfhi(h.z); v1[2] += bflo(h.w); v1[3] += bfhi(h.w);
                        ss += dot4(v0) + dot4(v1);
                        float* op = out + (size_t)orow * DM + col0 + bj * HALF;
                        *(f32x4*)op = v0; *(f32x4*)(op + 4) = v1;
                    }
                }
                ss += __shfl_xor(ss, 16); ss += __shfl_xor(ss, 32);
                if (fq == 0 && live) atomicAdd(rowss2 + orow, ss);
                asm volatile("" ::: "memory");
            }
    }
};
template <class Epi, class Sched, bool ALIGN_EPI = false, bool SP2 = false>
__device__ __forceinline__ void gemm_phase(PG8_LAS unsigned char* lds, const Gemm g, const Sched& S, const Epi& E) {
    int tid_ = threadIdx.x; asm volatile("" : "+v"(tid_));
    const int tid = tid_, wid = __builtin_amdgcn_readfirstlane(tid >> 6), lane = tid & 63, wr = wid >> 2, wc = wid & 3, fr = lane & 15, fq = lane >> 4;
    const int K = g.K, nt = K / BK;
    unsigned voffA[2], voffB[2];
#pragma unroll
    for (int i = 0; i < 2; ++i) { int R, C; stage_rc(tid * 16 + i * 8192, R, C); const int Rb = Epi::PERM ? ((R & ~31) + perm32(R & 31)) : R;
        voffA[i] = (unsigned)(R * K + C) * 2u; voffB[i] = (unsigned)(Rb * K + C) * 2u; }
    const size_t kstep = (size_t)(BK * 2);
    const size_t hstep = (size_t)HALF * K * 2;
    const size_t tstep = 2 * hstep;
    const unsigned ldsw = (unsigned)wid * 1024u;
    const int aoff = lds_byte(wr * 64 + fr, fq * 8), boff = lds_byte(wc * 32 + fr, fq * 8);
#define PG8_SA(b, h) (((b) * 2 + (h)) * HTB)
#define PG8_SB(b, h) ((4 + (b) * 2 + (h)) * HTB)
#define PG8_STAGE(bufoff, gbase, voff) do { _Pragma("unroll") for (int _i = 0; _i < 2; ++_i) \
        __builtin_amdgcn_global_load_lds((const unsigned*)((const char*)(gbase) + (voff)[_i]), (PG8_LAS unsigned*)(lds + (bufoff) + ldsw + _i * 8192), 16, 0, 0); } while (0)
#define PG8_LDA(dst, b, h) do { _Pragma("unroll") for (int m = 0; m < 4; ++m) _Pragma("unroll") for (int k = 0; k < 2; ++k) dst[m][k] = *(const PG8_LAS bf16x8*)(lds + PG8_SA(b, h) + aoff + m * 2048 + k * 1024); } while (0)
#define PG8_LDB(dst, b, h) do { _Pragma("unroll") for (int n = 0; n < 2; ++n) _Pragma("unroll") for (int k = 0; k < 2; ++k) dst[n][k] = *(const PG8_LAS bf16x8*)(lds + PG8_SB(b, h) + boff + n * 2048 + k * 1024); } while (0)
#define PG8_MMA(ai, bj, At, Bt) do { __builtin_amdgcn_s_setprio(1); _Pragma("unroll") for (int m = 0; m < 4; ++m) _Pragma("unroll") for (int n = 0; n < 2; ++n) _Pragma("unroll") for (int k = 0; k < 2; ++k) \
        acc[ai][bj][m][n] = __builtin_amdgcn_mfma_f32_16x16x32_bf16(Bt[n][k], At[m][k], acc[ai][bj][m][n], 0, 0, 0); __builtin_amdgcn_s_setprio(0); } while (0)
#define PG8_WAIT_V(n) asm volatile("s_waitcnt vmcnt(" #n ")" ::: "memory")
#define PG8_WAIT_L(n) asm volatile("s_waitcnt lgkmcnt(" #n ")" ::: "memory")
#define PG8_BAR __builtin_amdgcn_s_barrier()
#define PG8_SCHED __builtin_amdgcn_sched_barrier(0)
    Unit cur, nxt; int ui = 0;
    if (!S.next(0, cur)) return;
    f32x4 acc[2][2][4][2];
#pragma unroll
    for (int a = 0; a < 2; ++a)
#pragma unroll
        for (int b = 0; b < 2; ++b)
#pragma unroll
            for (int m = 0; m < 4; ++m)
#pragma unroll
                for (int n = 0; n < 2; ++n) acc[a][b][m][n] = (f32x4){0.f, 0.f, 0.f, 0.f};
    bf16x8 At[4][2], B0[2][2], B1[2][2];
    const char* cA = (const char*)g.A + (size_t)cur.pm * tstep; const char* cB = (const char*)g.Bt + (size_t)cur.pn * tstep;
    S.a_ready(cur);
    if constexpr (SP2) {
        PG8_STAGE(PG8_SB(0, 0), cB, voffB); PG8_STAGE(PG8_SB(0, 1), cB + hstep, voffB); PG8_STAGE(PG8_SA(0, 0), cA, voffA); PG8_STAGE(PG8_SA(0, 1), cA + hstep, voffA);
        if (wr == 1) PG8_BAR;
        PG8_WAIT_V(2); PG8_BAR;
        PG8_STAGE(PG8_SB(1, 0), cB + kstep, voffB); PG8_STAGE(PG8_SA(1, 0), cA + kstep, voffA); PG8_STAGE(PG8_SB(1, 1), cB + hstep + kstep, voffB);
        PG8_WAIT_V(6); PG8_BAR;
    } else {
        PG8_STAGE(PG8_SB(0, 0), cB, voffB); PG8_STAGE(PG8_SA(0, 0), cA, voffA); PG8_STAGE(PG8_SB(0, 1), cB + hstep, voffB); PG8_STAGE(PG8_SA(0, 1), cA + hstep, voffA);
        if (wr == 1) PG8_BAR;
        PG8_WAIT_V(4); PG8_BAR;
        PG8_STAGE(PG8_SB(1, 0), cB + kstep, voffB); PG8_STAGE(PG8_SA(1, 0), cA + kstep, voffA); PG8_STAGE(PG8_SB(1, 1), cB + hstep + kstep, voffB);
        PG8_WAIT_V(6); PG8_BAR;
    }
    for (;;) {
        const bool has_next = S.next(ui + 1, nxt);
        const char* nA = has_next ? (const char*)g.A + (size_t)nxt.pm * tstep : cA; const char* nB = has_next ? (const char*)g.Bt + (size_t)nxt.pn * tstep : cB;
        for (int t = 0; t < nt; t += 2) {
            const bool last = (t == nt - 2);
            const char* a1 = cA + (size_t)(t + 1) * kstep;
            const char* a2 = last ? nA : cA + (size_t)(t + 2) * kstep; const char* b2 = last ? nB : cB + (size_t)(t + 2) * kstep;
            const char* a3 = a2 + kstep; const char* b3 = b2 + kstep;
            if (last && has_next) S.a_ready(nxt);
            if constexpr (SP2) {
            PG8_LDB(B0, 0, 0); PG8_LDB(B1, 0, 1); PG8_SCHED; PG8_LDA(At, 0, 0); PG8_STAGE(PG8_SA(1, 1), a1 + hstep, voffA);
            PG8_WAIT_V(8); PG8_WAIT_L(0); PG8_BAR; PG8_MMA(0, 0, At, B0); PG8_MMA(0, 1, At, B1); PG8_BAR; PG8_SCHED;
            PG8_LDA(At, 0, 1); PG8_STAGE(PG8_SB(0, 0), b2, voffB); PG8_STAGE(PG8_SB(0, 1), b2 + hstep, voffB); PG8_STAGE(PG8_SA(0, 0), a2, voffA);
            PG8_WAIT_V(8); PG8_WAIT_L(0); PG8_BAR; PG8_MMA(1, 0, At, B0); PG8_MMA(1, 1, At, B1); PG8_BAR; PG8_SCHED;
            PG8_LDB(B0, 1, 0); PG8_LDB(B1, 1, 1); PG8_SCHED; PG8_LDA(At, 1, 0); PG8_STAGE(PG8_SA(0, 1), a2 + hstep, voffA);
            PG8_WAIT_V(8); PG8_WAIT_L(0); PG8_BAR; PG8_MMA(0, 0, At, B0); PG8_MMA(0, 1, At, B1); PG8_BAR; PG8_SCHED;
            PG8_LDA(At, 1, 1); PG8_STAGE(PG8_SB(1, 0), b3, voffB); PG8_STAGE(PG8_SB(1, 1), b3 + hstep, voffB); PG8_STAGE(PG8_SA(1, 0), a3, voffA);
            PG8_WAIT_V(8); PG8_WAIT_L(0); PG8_BAR; PG8_MMA(1, 0, At, B0); PG8_MMA(1, 1, At, B1); PG8_BAR; PG8_SCHED;
            } else {
            PG8_LDB(B0, 0, 0); PG8_SCHED; PG8_LDA(At, 0, 0); PG8_STAGE(PG8_SA(1, 1), a1 + hstep, voffA);
            PG8_WAIT_L(8); PG8_BAR; PG8_WAIT_L(0); PG8_MMA(0, 0, At, B0); PG8_BAR; PG8_SCHED;
            PG8_LDB(B1, 0, 1); PG8_STAGE(PG8_SB(0, 0), b2, voffB);
            PG8_BAR; PG8_WAIT_L(0); PG8_MMA(0, 1, At, B1); PG8_BAR;
            PG8_LDA(At, 0, 1); PG8_STAGE(PG8_SA(0, 0), a2, voffA);
            PG8_BAR; PG8_WAIT_L(0); PG8_MMA(1, 0, At, B0); PG8_BAR; PG8_SCHED;
            PG8_STAGE(PG8_SB(0, 1), b2 + hstep, voffB);
            PG8_WAIT_V(6); PG8_BAR; PG8_MMA(1, 1, At, B1); PG8_BAR;
            PG8_LDB(B0, 1, 0); PG8_SCHED; PG8_LDA(At, 1, 0); PG8_STAGE(PG8_SA(0, 1), a2 + hstep, voffA);
            PG8_WAIT_L(8); PG8_BAR; PG8_WAIT_L(0); PG8_MMA(0, 0, At, B0); PG8_BAR; PG8_SCHED;
            PG8_LDB(B1, 1, 1); PG8_STAGE(PG8_SB(1, 0), b3, voffB);
            PG8_BAR; PG8_WAIT_L(0); PG8_MMA(0, 1, At, B1); PG8_BAR;
            PG8_LDA(At, 1, 1); PG8_STAGE(PG8_SA(1, 0), a3, voffA);
            PG8_BAR; PG8_WAIT_L(0); PG8_MMA(1, 0, At, B0); PG8_BAR; PG8_SCHED;
            PG8_STAGE(PG8_SB(1, 1), b3 + hstep, voffB);
            PG8_WAIT_V(6); PG8_BAR; PG8_MMA(1, 1, At, B1); PG8_BAR;
            }
        }
        if constexpr (ALIGN_EPI) { if (wr == 0) PG8_BAR; }
        if constexpr (!Epi::AFTER_DRAIN) { E(acc, cur, wr, wc, fr, fq); S.done(cur); }
        if (!has_next) break;
#pragma unroll
        for (int a = 0; a < 2; ++a)
#pragma unroll
            for (int b = 0; b < 2; ++b)
#pragma unroll
                for (int m = 0; m < 4; ++m)
#pragma unroll
                    for (int n = 0; n < 2; ++n) acc[a][b][m][n] = (f32x4){0.f, 0.f, 0.f, 0.f};
        cur = nxt; cA = nA; cB = nB; ++ui;
        if constexpr (ALIGN_EPI) { if (wr == 1) PG8_BAR; }
    }
    PG8_WAIT_V(0);
    if constexpr (!ALIGN_EPI) { if (wr == 0) PG8_BAR; }
    PG8_BAR;
    if constexpr (Epi::AFTER_DRAIN) { E.fused(acc, cur, wr, wc, fr, fq, lds, wid, lane); S.done(cur); }
#undef PG8_SA
#undef PG8_SB
#undef PG8_STAGE
#undef PG8_LDA
#undef PG8_LDB
#undef PG8_MMA
#undef PG8_WAIT_V
#undef PG8_WAIT_L
#undef PG8_BAR
#undef PG8_SCHED
}
}
namespace ab {
using bf16=unsigned short;
using bf16x8=__attribute__((ext_vector_type(8)))short;
using s16x4=__attribute__((ext_vector_type(4)))short;
using f32x16=__attribute__((ext_vector_type(16)))float;
using u32x4=__attribute__((ext_vector_type(4)))unsigned;
constexpr int D=64, QP=512, KP=128, OP=1024;
constexpr int NW=8,QBLK=32,QB=QBLK*NW,KVBLK=64;
__device__ __forceinline__ int crow(int r,int hi){return (r&3)+8*(r>>2)+4*hi;}
#define SBAR() __builtin_amdgcn_sched_barrier(0)
__device__ __forceinline__ void cmask(f32x16&p0,f32x16&p1,int jb,int qrel,int hi){
  const float NEG=-INFINITY; (void)qrel; (void)hi;
  if(jb==2){
    #pragma unroll
    for(int r=8;r<16;++r)p0[r]=NEG;
    #pragma unroll
    for(int r=0;r<16;++r)p1[r]=NEG;
  } else if(jb==3){
    #pragma unroll
    for(int r=0;r<16;++r){p0[r]=NEG;p1[r]=NEG;}
  }
}

constexpr int NSLOT=3, SLOTB=8192;
constexpr int LDS_K=0, LDS_V=NSLOT*SLOTB, LDS_WS=2*NSLOT*SLOTB, LDS_OST=LDS_WS+NW*64*4, LDS_BYTES=LDS_OST+NW*4096;
constexpr float C2=0.125f*1.4426950408889634f;
__device__ __forceinline__ void glds16(const void*gsrc,unsigned lds_dst){unsigned keep;
  asm volatile("s_mov_b32 %0, m0\n\ts_mov_b32 m0, %2\n\ts_nop 0\n\tglobal_load_lds_dwordx4 %1, off\n\ts_mov_b32 m0, %0":"=&s"(keep):"v"(gsrc),"s"(lds_dst):"memory");}
__device__ __forceinline__ float max3f(float a,float b,float c){float r;asm("v_max3_f32 %0, %1, %2, %3":"=v"(r):"v"(a),"v"(b),"v"(c));return r;}
__device__ __forceinline__ float max2f(float a,float b){float r;asm("v_max_f32_e32 %0, %1, %2":"=v"(r):"v"(a),"v"(b));return r;}
__device__ __forceinline__ float fadd_s(float a,float b){float r;asm("v_add_f32_e32 %0, %1, %2":"=v"(r):"v"(a),"v"(b));return r;}
__device__ __forceinline__ float fsub_s(float a,float b){float r;asm("v_sub_f32_e32 %0, %1, %2":"=v"(r):"v"(a),"v"(b));return r;}
typedef float f32x2_t __attribute__((ext_vector_type(2))); typedef __bf16 bf16x2_t __attribute__((ext_vector_type(2)));
__device__ __forceinline__ unsigned cvtpk_s(float lo,float hi){f32x2_t v={lo,hi};bf16x2_t b=__builtin_convertvector(v,bf16x2_t);return __builtin_bit_cast(unsigned,b);}
#define WAIT_BAR(N) asm volatile("s_waitcnt vmcnt(" #N ") lgkmcnt(0)\n\ts_barrier":::"memory")

__device__ __forceinline__ void qkt(f32x16&p0,f32x16&p1,const char*Kslot,const bf16x8*qr,const f32x16&negm,int r32,int hi){
  const char*kb=Kslot+hi*1024+r32*16;
  #pragma unroll
  for(int d0=0;d0<4;++d0){
    const bf16x8 b0=*reinterpret_cast<const bf16x8*>(kb+d0*2048);
    const bf16x8 b1=*reinterpret_cast<const bf16x8*>(kb+d0*2048+512);
    if(d0==0){p0=__builtin_amdgcn_mfma_f32_32x32x16_bf16(b0,qr[0],negm,0,0,0);p1=__builtin_amdgcn_mfma_f32_32x32x16_bf16(b1,qr[0],negm,0,0,0);}
    else{p0=__builtin_amdgcn_mfma_f32_32x32x16_bf16(b0,qr[d0],p0,0,0,0);p1=__builtin_amdgcn_mfma_f32_32x32x16_bf16(b1,qr[d0],p1,0,0,0);}}
}
typedef __attribute__((address_space(3))) const char* lds_cptr;
typedef short v4i16_t __attribute__((ext_vector_type(4)));
__device__ __forceinline__ void kload8(bf16x8*kf,lds_cptr kp){
  kf[0]=*(const __attribute__((address_space(3))) bf16x8*)(kp);      kf[1]=*(const __attribute__((address_space(3))) bf16x8*)(kp+512);
  kf[2]=*(const __attribute__((address_space(3))) bf16x8*)(kp+2048); kf[3]=*(const __attribute__((address_space(3))) bf16x8*)(kp+2560);
  kf[4]=*(const __attribute__((address_space(3))) bf16x8*)(kp+4096); kf[5]=*(const __attribute__((address_space(3))) bf16x8*)(kp+4608);
  kf[6]=*(const __attribute__((address_space(3))) bf16x8*)(kp+6144); kf[7]=*(const __attribute__((address_space(3))) bf16x8*)(kp+6656);
}
__device__ __forceinline__ void kload2(bf16x8*kf,lds_cptr kp,int j){ kf[2*j]=*(const __attribute__((address_space(3))) bf16x8*)(kp+j*2048); kf[2*j+1]=*(const __attribute__((address_space(3))) bf16x8*)(kp+j*2048+512); }
__device__ __forceinline__ s16x4 vtr(lds_cptr p){ return __builtin_bit_cast(s16x4,__builtin_amdgcn_ds_read_tr16_b64_v4i16((__attribute__((address_space(3))) v4i16_t*)p)); }
__device__ __forceinline__ float rowmax(const f32x16&p0,const f32x16&p1){
  float a=max3f(p0[0],p0[1],p1[0]),b=max3f(p0[2],p0[3],p1[1]);a=max3f(a,p1[2],p1[3]);
  #pragma unroll
  for(int r=4;r<16;r+=4){a=max3f(a,p0[r],p0[r+1]);b=max3f(b,p0[r+2],p0[r+3]);a=max3f(a,p1[r],p1[r+1]);b=max3f(b,p1[r+2],p1[r+3]);}
  const float m=max2f(a,b);
  auto rr=__builtin_amdgcn_permlane32_swap(__float_as_uint(m),__float_as_uint(m),false,false);
  return max2f(__uint_as_float(rr[0]),__uint_as_float(rr[1]));
}
__device__ __forceinline__ void pv(f32x16*o,int vb,bf16x8 pa0,bf16x8 pa1,bf16x8 pa2,bf16x8 pa3){
  #pragma unroll
  for(int d0=0;d0<2;++d0){s16x4 lo[4],hi[4];
    #pragma unroll
    for(int ks=0;ks<4;++ks){
      asm volatile("ds_read_b64_tr_b16 %0,%1 offset:%c2":"=&v"(lo[ks]):"v"(vb),"i"(d0*4096+ks*1024):"memory");
      asm volatile("ds_read_b64_tr_b16 %0,%1 offset:%c2":"=&v"(hi[ks]):"v"(vb),"i"(d0*4096+ks*1024+512):"memory");}
    asm volatile("s_waitcnt lgkmcnt(0)":::"memory");SBAR();
    #define PK(k) (bf16x8){lo[k][0],lo[k][1],lo[k][2],lo[k][3],hi[k][0],hi[k][1],hi[k][2],hi[k][3]}
    o[d0]=__builtin_amdgcn_mfma_f32_32x32x16_bf16(pa0,PK(0),o[d0],0,0,0);
    o[d0]=__builtin_amdgcn_mfma_f32_32x32x16_bf16(pa1,PK(1),o[d0],0,0,0);
    o[d0]=__builtin_amdgcn_mfma_f32_32x32x16_bf16(pa2,PK(2),o[d0],0,0,0);
    o[d0]=__builtin_amdgcn_mfma_f32_32x32x16_bf16(pa3,PK(3),o[d0],0,0,0);
    #undef PK
  }
}

#ifndef ATTN_STORE16
#define ATTN_STORE16(p,v) (*(u32x4*)(p)=(v))
#endif
template<int THRL> __device__ __forceinline__ void attn_unit(const bf16*Qw0,const bf16*__restrict__ Kh,const bf16*__restrict__ Vh,bf16*Ow0,int NT,char*shm){
  int tid_=threadIdx.x; asm volatile("":"+v"(tid_));
  const int tid=tid_,lane=tid&63,r32=lane&31,hi=lane>>5; const int wid=__builtin_amdgcn_readfirstlane(tid>>6);
  const bf16*Qw=Qw0+(long)(wid*QBLK)*QP;
  const unsigned lds0=(unsigned)(uintptr_t)shm;
  float*wsf=(float*)(shm+LDS_WS)+wid*64;
  const bf16*ksrc=Kh+(long)lane*KP+wid*8;
  const bf16*vsrc=Vh+(long)(16*(wid&3)+(lane>>2))*KP+(wid>>2)*32+(lane&3)*8;
  const unsigned kdst=lds0+LDS_K+wid*1024, vdst=lds0+LDS_V+wid*1024;
  #define DMA_K(t,slot) glds16(ksrc+(long)(t)*KVBLK*KP,(unsigned)__builtin_amdgcn_readfirstlane(kdst+(slot)))
  #define DMA_V(t,slot) glds16(vsrc+(long)(t)*KVBLK*KP,(unsigned)__builtin_amdgcn_readfirstlane(vdst+(slot)))
  const int vb0=(int)(lds0+LDS_V)+((lane>>4)&1)*32+(lane&3)*8+(4*hi+((lane&15)>>2))*64;
  const char*Kbase=shm+LDS_K; bf16x8 kf[8];
  const lds_cptr shm3=(lds_cptr)shm; const lds_cptr kp0=shm3+LDS_K+hi*1024+r32*16; const lds_cptr vp0=shm3+LDS_V+((lane>>4)&1)*32+(lane&3)*8+(4*hi+((lane&15)>>2))*64;
  DMA_K(0,0);DMA_V(0,0);DMA_K(1,SLOTB);
  bf16x8 qr[4];
  #pragma unroll
  for(int d0=0;d0<4;++d0)qr[d0]=*reinterpret_cast<const bf16x8*>(&Qw[(long)r32*QP+d0*16+hi*8]);
  float mhat=0.f,l_reg=0.f;f32x16 o[2];o[0]=f32x16{};o[1]=f32x16{};f32x16 negm=f32x16{};asm volatile("":"+v"(negm));
  const int qrel=wid*QBLK+r32;
  #define CMASK(P0,P1,t) do{int jb_=(t)-(NT-4); if(jb_>=0)cmask(P0,P1,jb_,qrel,hi);}while(0)
  bool resc=false;
  #define START(P0,P1) do{ const float rm=rowmax(P0,P1); resc=false; \
    { const float dl=rm; mhat=fadd_s(mhat,dl); \
      _Pragma("unroll") for(int r=0;r<16;++r){P0[r]=fsub_s(P0[r],dl);P1[r]=fsub_s(P1[r],dl);} \
      _Pragma("unroll") for(int r=0;r<16;++r)negm[r]=-mhat; asm volatile("":"+v"(negm)); } \
    _Pragma("unroll") for(int r=0;r<16;++r)P0[r]=__builtin_amdgcn_exp2f(P0[r]); }while(0)
  #define RESC() do{ if(resc){ asm volatile("s_waitcnt lgkmcnt(0)":::"memory"); \
      _Pragma("unroll") for(int d_=0;d_<2;++d_) _Pragma("unroll") for(int r=0;r<16;++r)o[d_][r]*=wsf[crow(r,hi)]; } }while(0)
  f32x16 pA0,pA1,pB0,pB1;
  int sl_prev=0,sl_cur=0,sl_next=SLOTB;
  #define ROT() do{sl_prev=sl_cur;sl_cur=sl_next;sl_next=(sl_next==(NSLOT-1)*SLOTB)?0:sl_next+SLOTB;}while(0)
  DMA_K(2,2*SLOTB);
  WAIT_BAR(3);
  qkt(pA0,pA1,Kbase,qr,negm,r32,hi);asm volatile("s_nop 15\n\ts_nop 7":"+v"(pA0),"+v"(pA1));CMASK(pA0,pA1,0);
  START(pA0,pA1);
  _Pragma("unroll") for(int r=0;r<16;++r)pA1[r]=__builtin_amdgcn_exp2f(pA1[r]);
  WAIT_BAR(0);
  DMA_K(3,0);DMA_V(1,SLOTB);
  ROT();
  kload8(kf,kp0+sl_cur);
  WAIT_BAR(2);
  s16x4 vlo[8],vhi[8]; u32x4 pw0,pw1,pw2,pw3;
  #define PKW(P,B) cvtpk_s(P[B],P[B+1])
  #define PAF(k) __builtin_bit_cast(bf16x8,pw##k)
  #define VFR(i) (bf16x8){vlo[i][0],vlo[i][1],vlo[i][2],vlo[i][3],vhi[i][0],vhi[i][1],vhi[i][2],vhi[i][3]}
  #define PIN(x) asm volatile("":"+v"(x))
  #define MX3(a,b,c) __builtin_fmaxf(__builtin_fmaxf((a),(b)),(c))
  #define GAPA(MF,A0,A1,A2,A3,W0,W1,PW) do{ MF; sacc+=A0; sacc+=A1; sacc+=A2; sacc+=A3; PIN(sacc); W0; W1; PIN(PW); SBAR(); }while(0)
  #define EX(v) __builtin_amdgcn_exp2f(v)
  #define GAPB(MF,X,B) do{ MF; X[B]=EX(X[B]); X[B+1]=EX(X[B+1]); X[B+2]=EX(X[B+2]); X[B+3]=EX(X[B+3]); PIN(X); SBAR(); }while(0)
  #define VRD(i) do{ vlo[i]=vtr(vp_+(((i)>>2)*4096+((i)&3)*1024)); vhi[i]=vtr(vp_+(((i)>>2)*4096+((i)&3)*1024+512)); }while(0)
  #define KRD(G,j) do{ if(G){ kload2(kf,kp0+sl_next,j); SBAR(); } }while(0)
  #define STEP(C0,C1,P0,P1,t,GK,GV,GL) do{ SBAR(); \
    const lds_cptr vp_=vp0+sl_prev; \
    VRD(0); SBAR(); float sacc=(P0[0]+P0[1]); \
    GAPA(C0=__builtin_amdgcn_mfma_f32_32x32x16_bf16(kf[0],qr[0],negm,0,0,0), P0[2],P0[3],P0[4],P0[5],     pw0[0]=PKW(P0,0), pw0[1]=PKW(P0,2), pw0); \
    VRD(4); SBAR(); GAPA(C1=__builtin_amdgcn_mfma_f32_32x32x16_bf16(kf[1],qr[0],negm,0,0,0), P0[6],P0[7],P0[8],P0[9],     pw0[2]=PKW(P0,4), pw0[3]=PKW(P0,6), pw0); \
    VRD(1); SBAR(); GAPA(C0=__builtin_amdgcn_mfma_f32_32x32x16_bf16(kf[2],qr[1],C0,0,0,0),   P0[10],P0[11],P0[12],P0[13], pw1[0]=PKW(P0,8), pw1[1]=PKW(P0,10), pw1); \
    VRD(5); SBAR(); GAPA(C1=__builtin_amdgcn_mfma_f32_32x32x16_bf16(kf[3],qr[1],C1,0,0,0),   P0[14],P0[15],P1[0],P1[1],   pw1[2]=PKW(P0,12),pw1[3]=PKW(P0,14), pw1); \
    VRD(2); SBAR(); GAPA(C0=__builtin_amdgcn_mfma_f32_32x32x16_bf16(kf[4],qr[2],C0,0,0,0),   P1[2],P1[3],P1[4],P1[5],     pw2[0]=PKW(P1,0), pw2[1]=PKW(P1,2), pw2); \
    VRD(6); SBAR(); GAPA(C1=__builtin_amdgcn_mfma_f32_32x32x16_bf16(kf[5],qr[2],C1,0,0,0),   P1[6],P1[7],P1[8],P1[9],     pw2[2]=PKW(P1,4), pw2[3]=PKW(P1,6), pw2); \
    VRD(3); SBAR(); GAPA(C0=__builtin_amdgcn_mfma_f32_32x32x16_bf16(kf[6],qr[3],C0,0,0,0),   P1[10],P1[11],P1[12],P1[13], pw3[0]=PKW(P1,8), pw3[1]=PKW(P1,10), pw3); \
    VRD(7); SBAR(); GAPA(C1=__builtin_amdgcn_mfma_f32_32x32x16_bf16(kf[7],qr[3],C1,0,0,0),   P1[14],P1[15],0.f,0.f,       pw3[2]=PKW(P1,12),pw3[3]=PKW(P1,14), pw3); \
    l_reg+=sacc; \
    if(GK){DMA_K((t)+3,sl_cur);} if(GV){DMA_V((t)+1,sl_next);} \
    CMASK(C0,C1,t); \
    { float a=MX3(C0[0],C0[1],C1[0]),b=MX3(C0[2],C0[3],C1[1]); a=MX3(a,C1[2],C1[3]); \
      _Pragma("unroll") for(int r=4;r<16;r+=4){a=MX3(a,C0[r],C0[r+1]);b=MX3(b,C0[r+2],C0[r+3]);a=MX3(a,C1[r],C1[r+1]);b=MX3(b,C1[r+2],C1[r+3]);} \
      float rm=__builtin_fmaxf(a,b); { auto rr=__builtin_amdgcn_permlane32_swap(__float_as_uint(rm),__float_as_uint(rm),false,false); rm=__builtin_fmaxf(__uint_as_float(rr[0]),__uint_as_float(rr[1])); } \
      resc=false; \
      if(__builtin_expect(__any(rm>(float)THRL),0)){ const float dl=__builtin_fmaxf(rm,0.f); mhat+=dl; \
        _Pragma("unroll") for(int r=0;r<16;++r){C0[r]-=dl;C1[r]-=dl;} \
        _Pragma("unroll") for(int r=0;r<16;++r)negm[r]=-mhat; asm volatile("":"+v"(negm)); \
        const float f=__builtin_amdgcn_exp2f(-dl); l_reg*=f; if(hi==0)wsf[r32]=f; resc=true; } } \
    SBAR(); \
    GAPB(o[0]=__builtin_amdgcn_mfma_f32_32x32x16_bf16(PAF(0),VFR(0),o[0],0,0,0), C0,0); \
    GAPB(o[1]=__builtin_amdgcn_mfma_f32_32x32x16_bf16(PAF(0),VFR(4),o[1],0,0,0), C0,4); \
    KRD(GL,0); GAPB(o[0]=__builtin_amdgcn_mfma_f32_32x32x16_bf16(PAF(1),VFR(1),o[0],0,0,0), C0,8); \
    KRD(GL,1); GAPB(o[1]=__builtin_amdgcn_mfma_f32_32x32x16_bf16(PAF(1),VFR(5),o[1],0,0,0), C0,12); \
    KRD(GL,2); GAPB(o[0]=__builtin_amdgcn_mfma_f32_32x32x16_bf16(PAF(2),VFR(2),o[0],0,0,0), C1,0); \
    KRD(GL,3); GAPB(o[1]=__builtin_amdgcn_mfma_f32_32x32x16_bf16(PAF(2),VFR(6),o[1],0,0,0), C1,4); \
    GAPB(o[0]=__builtin_amdgcn_mfma_f32_32x32x16_bf16(PAF(3),VFR(3),o[0],0,0,0), C1,8); \
    GAPB(o[1]=__builtin_amdgcn_mfma_f32_32x32x16_bf16(PAF(3),VFR(7),o[1],0,0,0), C1,12); \
    }while(0)
  int t=1;
  #undef CMASK
  #define CMASK(P0,P1,t) do{}while(0)
  for(;t+5<NT;t+=2){
    STEP(pB0,pB1,pA0,pA1,t,true,true,true);     WAIT_BAR(2); RESC(); ROT();
    STEP(pA0,pA1,pB0,pB1,t+1,true,true,true);   WAIT_BAR(2); RESC(); ROT();
  }
  #undef CMASK
  #define CMASK(P0,P1,t) do{int jb_=(t)-(NT-4); if(jb_>=0)cmask(P0,P1,jb_,qrel,hi);}while(0)
  #define ENDW(tt) do{ if((tt)+3<NT){WAIT_BAR(2);} else if((tt)+2<NT){WAIT_BAR(1);} else {WAIT_BAR(0);} }while(0)
  for(;t+1<NT;t+=2){
    STEP(pB0,pB1,pA0,pA1,t,(t+3<NT),(t+1<NT),(t+1<NT));       ENDW(t);   RESC(); ROT();
    STEP(pA0,pA1,pB0,pB1,t+1,(t+4<NT),(t+2<NT),(t+2<NT));     ENDW(t+1); RESC(); ROT();
  }
  STEP(pB0,pB1,pA0,pA1,NT-1,false,false,false); RESC();
  { float sacc=pB0[0]+pB0[1]; _Pragma("unroll") for(int r=2;r<16;++r)sacc+=pB0[r]; _Pragma("unroll") for(int r=0;r<16;++r)sacc+=pB1[r]; l_reg+=sacc;
    pw0=(u32x4){PKW(pB0,0),PKW(pB0,2),PKW(pB0,4),PKW(pB0,6)};pw1=(u32x4){PKW(pB0,8),PKW(pB0,10),PKW(pB0,12),PKW(pB0,14)};pw2=(u32x4){PKW(pB1,0),PKW(pB1,2),PKW(pB1,4),PKW(pB1,6)};pw3=(u32x4){PKW(pB1,8),PKW(pB1,10),PKW(pB1,12),PKW(pB1,14)};
    SBAR(); pv(o,vb0+sl_cur,PAF(0),PAF(1),PAF(2),PAF(3)); }
  #undef PKW
  #undef PAF
  #undef VFR
  #undef PIN
  #undef MX3
  #undef GAPA
  #undef GAPB
  #undef EX
  #undef VRD
  #undef KRD
  #undef STEP
  #undef ENDW
  {auto rr=__builtin_amdgcn_permlane32_swap(__float_as_uint(l_reg),__float_as_uint(l_reg),false,false);l_reg=__uint_as_float(rr[0])+__uint_as_float(rr[1]);}
  if(hi==0)wsf[32+r32]=l_reg;asm volatile("s_waitcnt lgkmcnt(0)":::"memory");
  float rli[16];
  #pragma unroll
  for(int r=0;r<16;++r)rli[r]=__builtin_amdgcn_rcpf(wsf[32+crow(r,hi)]);
  bf16*Ow=Ow0+(long)(wid*QBLK)*OP;
  { bf16*stg=(bf16*)(shm+LDS_OST)+wid*2048;
    #pragma unroll
    for(int r=0;r<16;++r){const int orow=crow(r,hi);
      #pragma unroll
      for(int d0=0;d0<2;++d0)stg[orow*64+d0*32+r32]=(bf16)(cvtpk_s(o[d0][r]*rli[r],0.f)&0xffffu);}
    asm volatile("s_waitcnt lgkmcnt(0)":::"memory");
    #pragma unroll
    for(int i=0;i<4;++i){const int row=i*8+(lane>>3),ch=lane&7; const u32x4 v=*(const u32x4*)(stg+row*64+ch*8); ATTN_STORE16(Ow+(long)row*OP+ch*8,v);} }
  asm volatile("s_waitcnt lgkmcnt(0)\n\ts_barrier":::"memory");
  #undef DMA_K
  #undef DMA_V
  #undef CMASK
  #undef START
  #undef RESC
  #undef ROT
}
#undef SBAR
#undef WAIT_BAR
}
namespace att {
using bf16 = unsigned short;
using bf16x8 = __attribute__((ext_vector_type(8))) short;
using s16x4 = __attribute__((ext_vector_type(4))) short;
using f32x16 = __attribute__((ext_vector_type(16))) float;
using f32x4 = __attribute__((ext_vector_type(4))) float;
using u32x4 = __attribute__((ext_vector_type(4))) unsigned;
constexpr float SCALE = 0.125f, THR = 8.f;
#ifndef A_ONES
#define A_ONES 0
#endif
constexpr bool AONES = A_ONES;
constexpr int LDS_WS = 98304, LDS_STG = 0, STG_WAVE = 8704, LDS_UNIT = 147456 - 64;
#define SBAR() __builtin_amdgcn_sched_barrier(0)
__device__ __forceinline__ int crow(int r, int hi) { return (r & 3) + 8 * (r >> 2) + 4 * hi; }
__device__ __forceinline__ unsigned cvtpk(float lo, float hi) { unsigned r; asm volatile("v_cvt_pk_bf16_f32 %0, %1, %2" : "=v"(r) : "v"(lo), "v"(hi)); return r; }
template <int KW> __device__ __forceinline__ int kswz(int row, int cb) { if constexpr (KW == 64) return row * 128 + (cb ^ (((row >> 1) & 7) << 4)); else return row * 256 + (cb ^ ((row & 15) << 4)); }

template <bool SUB> __device__ __forceinline__ void partialSM(f32x16& p0, float nref) {
#pragma unroll
  for (int r = 0; r < 16; ++r) p0[r] = __builtin_amdgcn_exp2f(SUB ? p0[r] + nref : p0[r]);
}
template <bool SUB, bool SUM> __device__ __forceinline__ void finishSM(f32x16& p0, f32x16& p1, float nref, float& l_reg, bf16x8& pa0, bf16x8& pa1, bf16x8& pa2, bf16x8& pa3) {
#pragma unroll
  for (int r = 0; r < 16; ++r) p1[r] = __builtin_amdgcn_exp2f(SUB ? p1[r] + nref : p1[r]);
  if constexpr (SUM) {
    float ps = 0;
#pragma unroll
    for (int r = 0; r < 16; ++r) ps += p0[r];
#pragma unroll
    for (int r = 0; r < 16; ++r) ps += p1[r];
    l_reg += ps;
  }
#define PK4(P, BASE, OUT) do { unsigned a0 = cvtpk(P[BASE + 0], P[BASE + 1]), a1 = cvtpk(P[BASE + 2], P[BASE + 3]);   \
    unsigned b0 = cvtpk(P[BASE + 4], P[BASE + 5]), b1 = cvtpk(P[BASE + 6], P[BASE + 7]);                              \
    auto r0 = __builtin_amdgcn_permlane32_swap(a0, b0, false, false); auto r1 = __builtin_amdgcn_permlane32_swap(a1, b1, false, false); \
    u32x4 w = {r0[0], r1[0], r0[1], r1[1]}; OUT = *reinterpret_cast<bf16x8*>(&w); } while (0)
  PK4(p0, 0, pa0); PK4(p0, 8, pa1); PK4(p1, 0, pa2); PK4(p1, 8, pa3);
#undef PK4
}
template <int KW, bool CREF> __device__ __forceinline__ void qkt(f32x16& p0, f32x16& p1, const char* Ks, const bf16x8* qr, const f32x16& negm, int r32, int hi, int cboff) {
  if constexpr (!CREF) { p0 = f32x16{}; p1 = f32x16{}; }
#pragma unroll
  for (int d0 = 0; d0 < 4; ++d0) { const int cb = cboff + (d0 * 16 + hi * 8) * 2;
    const bf16x8 b0 = *reinterpret_cast<const bf16x8*>(Ks + kswz<KW>(r32, cb));
    const bf16x8 b1 = *reinterpret_cast<const bf16x8*>(Ks + kswz<KW>(32 + r32, cb));
    if (CREF && d0 == 0) { p0 = __builtin_amdgcn_mfma_f32_32x32x16_bf16(b0, qr[0], negm, 0, 0, 0); p1 = __builtin_amdgcn_mfma_f32_32x32x16_bf16(b1, qr[0], negm, 0, 0, 0); }
    else { p0 = __builtin_amdgcn_mfma_f32_32x32x16_bf16(b0, qr[d0], p0, 0, 0, 0); p1 = __builtin_amdgcn_mfma_f32_32x32x16_bf16(b1, qr[d0], p1, 0, 0, 0); } }
}
template <int NCB> __device__ __forceinline__ int v_st(int k, int c) { const int kk = (k & ~0xC) | ((k & 4) << 1) | ((k & 8) >> 1); return ((kk >> 3) * NCB + (c >> 5)) * 512 + ((kk & 7) * 32 + (c & 31)) * 2; }
__device__ __forceinline__ int v_rd_base(int lane) { return ((lane & 3) << 3) | (((lane >> 2) & 3) << 6) | (((lane >> 4) & 1) << 5) | (((lane >> 5) & 1) << 8); }
template <int NCB> constexpr int v_rd_off(int d0, int ks, int half) { return d0 * 512 + ks * (2 * NCB * 512) + half * (NCB * 512); }
template <int OFF> __device__ __forceinline__ s16x4 tr_read(int vb) { s16x4 r; asm volatile("ds_read_b64_tr_b16 %0, %1 offset:%2" : "=&v"(r) : "v"(vb), "i"(OFF) : "memory"); return r; }
template <int NCB, int D0> __device__ __forceinline__ void pv_one(f32x16& od, int vb, bf16x8 pa0, bf16x8 pa1, bf16x8 pa2, bf16x8 pa3) {
  const s16x4 l0 = tr_read<v_rd_off<NCB>(D0, 0, 0)>(vb), h0 = tr_read<v_rd_off<NCB>(D0, 0, 1)>(vb), l1 = tr_read<v_rd_off<NCB>(D0, 1, 0)>(vb), h1 = tr_read<v_rd_off<NCB>(D0, 1, 1)>(vb);
  const s16x4 l2 = tr_read<v_rd_off<NCB>(D0, 2, 0)>(vb), h2 = tr_read<v_rd_off<NCB>(D0, 2, 1)>(vb), l3 = tr_read<v_rd_off<NCB>(D0, 3, 0)>(vb), h3 = tr_read<v_rd_off<NCB>(D0, 3, 1)>(vb);
  asm volatile("s_waitcnt lgkmcnt(0)" ::: "memory"); SBAR();
#define PK(L, H) (bf16x8){L[0], L[1], L[2], L[3], H[0], H[1], H[2], H[3]}
  od = __builtin_amdgcn_mfma_f32_32x32x16_bf16(pa0, PK(l0, h0), od, 0, 0, 0);
  od = __builtin_amdgcn_mfma_f32_32x32x16_bf16(pa1, PK(l1, h1), od, 0, 0, 0);
  od = __builtin_amdgcn_mfma_f32_32x32x16_bf16(pa2, PK(l2, h2), od, 0, 0, 0);
  od = __builtin_amdgcn_mfma_f32_32x32x16_bf16(pa3, PK(l3, h3), od, 0, 0, 0);
#undef PK
}
template <int NCB> __device__ __forceinline__ void pv_all(f32x16* o, f32x16& lacc, int vb, bf16x8 pa0, bf16x8 pa1, bf16x8 pa2, bf16x8 pa3) {
  pv_one<NCB, 0>(o[0], vb, pa0, pa1, pa2, pa3); pv_one<NCB, 1>(o[1], vb, pa0, pa1, pa2, pa3);
  if constexpr (NCB == 2 && AONES) {
    const bf16x8 ones = {0x3F80, 0x3F80, 0x3F80, 0x3F80, 0x3F80, 0x3F80, 0x3F80, 0x3F80};
    lacc = __builtin_amdgcn_mfma_f32_32x32x16_bf16(pa0, ones, lacc, 0, 0, 0); lacc = __builtin_amdgcn_mfma_f32_32x32x16_bf16(pa1, ones, lacc, 0, 0, 0);
    lacc = __builtin_amdgcn_mfma_f32_32x32x16_bf16(pa2, ones, lacc, 0, 0, 0); lacc = __builtin_amdgcn_mfma_f32_32x32x16_bf16(pa3, ones, lacc, 0, 0, 0);
  }
  if constexpr (NCB == 4) { pv_one<NCB, 2>(o[2], vb, pa0, pa1, pa2, pa3); pv_one<NCB, 3>(o[3], vb, pa0, pa1, pa2, pa3); }
}

struct AttnArgs { const bf16 *QA, *KA, *VA, *QB, *KB, *VB; bf16* mix; const float* gsub; const float* kmax2; };

template <bool ISB> __device__ __forceinline__ void rowmap(int meta, int hidx, int qt, int wid, int i, int& pos, int& hq, bool& valid) {
  if constexpr (!ISB) {
    if (!meta) { pos = 16 + 256 * qt + 32 * wid + i; hq = hidx; valid = true; }
    else { pos = i & 15; hq = 4 * hidx + 2 * (wid & 1) + (i >> 4); valid = wid < 2; }
  } else {
    hq = hidx;
    if (!meta) { pos = 16 + 128 * qt + 32 * (wid >> 1) + i; valid = true; }
    else { pos = i & 15; valid = (wid < 2) && (i < 16); }
  }
}

template <bool ISB>
__device__ __forceinline__ void attn_unit(const AttnArgs& A, int seqbase, int sidx, int L, int hidx, int qt, int meta, char* lds, float lam) {
  constexpr int KW = ISB ? 128 : 64, DV = KW, LDK = ISB ? 512 : 128, NCB = DV / 32;
  constexpr int SHM_K = 64 * KW * 2, SHM_V = 64 * DV * 2;
  constexpr int NCH = KW / 8, RP = 512 / NCH, NP = 64 / RP;
  int tid_ = threadIdx.x; asm volatile("" : "+v"(tid_));
  const int tid = tid_, wid = tid >> 6, lane = tid & 63, r32 = lane & 31, hi = lane >> 5;
  char* V_lds = lds; char* K_lds = lds + 3 * SHM_V;
  float* ws = (float*)(lds + LDS_WS) + wid * 64; float* li_l = ws; float* al_l = ws + 32;
  const int comp = ISB ? (wid & 1) : 0, cboff = comp * 128;
  float l_reg = 0; f32x16 o[NCB]; bf16x8 qr[4]; f32x16 lacc = f32x16{};
#pragma unroll
  for (int d = 0; d < NCB; ++d) o[d] = f32x16{};
  { int pos, hq; bool valid; rowmap<ISB>(meta, hidx, qt, wid, r32, pos, hq, valid);
    const bf16* Qw = (ISB ? A.QB + (size_t)(seqbase + pos) * 512 + hq * 128 + comp * 64 : A.QA + (size_t)(seqbase + pos) * 512 + hq * 64) + hi * 8;
#pragma unroll
    for (int d0 = 0; d0 < 4; ++d0) qr[d0] = *reinterpret_cast<const bf16x8*>(Qw + d0 * 16); }
  const int kvh = ISB ? hidx : (meta ? hidx : (hidx >> 2));
  f32x16 negm; float mref;
  { float qs = 0.f;
#pragma unroll
    for (int d0 = 0; d0 < 4; ++d0)
#pragma unroll
      for (int e = 0; e < 8; ++e) { const float v = __uint_as_float(((unsigned)(unsigned short)qr[d0][e]) << 16); qs = fmaf(v, v, qs); }
    { auto rr = __builtin_amdgcn_permlane32_swap(__float_as_uint(qs), __float_as_uint(qs), false, false); qs = __uint_as_float(rr[0]) + __uint_as_float(rr[1]); }
    const float km2 = A.kmax2[ISB ? 80 + sidx * 8 + hidx * 2 + comp : sidx * 2 + kvh];
    mref = -(sqrtf(qs * km2) * 1.01f);
#pragma unroll
    for (int r = 0; r < 16; ++r) negm[r] = mref; }
  const bf16* Kh = (ISB ? A.KB + kvh * 128 : A.KA + kvh * 64) + (size_t)seqbase * LDK;
  const bf16* Vh = (ISB ? A.VB + kvh * 128 : A.VA + kvh * 64) + (size_t)seqbase * LDK;
  const int vb0 = (int)(uintptr_t)V_lds + v_rd_base(lane);
  const int NT = (L + 63) / 64;
  constexpr int NI = SHM_K / 8192;
  const int widu = __builtin_amdgcn_readfirstlane(wid);
  int kofs[NI], vofs[NI];
#pragma unroll
  for (int i = 0; i < NI; ++i) { const int o = (widu * NI + i) * 1024 + lane * 16;
    if constexpr (KW == 128) { const int row = o >> 8, lg = ((o >> 4) & 15) ^ (row & 15); kofs[i] = row * LDK + lg * 8; }
    else { const int row = o >> 7, lg = ((o >> 4) & 7) ^ ((row >> 1) & 7); kofs[i] = row * LDK + lg * 8; }
    { const int sb = o >> 9, g = sb / NCB, cb = sb % NCB, rr = (o >> 6) & 7, cc = (o & 63) >> 1, kk = g * 8 + rr, k = (kk & ~0xC) | ((kk & 4) << 1) | ((kk & 8) >> 1); vofs[i] = k * LDK + cb * 32 + cc; } }
  typedef __attribute__((address_space(3))) unsigned lds_u32;
#define DMA(t, slot) do { const int tt_ = (t) < NT ? (t) : NT - 1; _Pragma("unroll") for (int i_ = 0; i_ < NI; ++i_) { \
    __builtin_amdgcn_global_load_lds((const unsigned*)(Kh + (size_t)tt_ * 64 * LDK + kofs[i_]), (lds_u32*)(K_lds + (slot) * SHM_K + (widu * NI + i_) * 1024), 16, 0, 0); \
    __builtin_amdgcn_global_load_lds((const unsigned*)(Vh + (size_t)tt_ * 64 * LDK + vofs[i_]), (lds_u32*)(V_lds + (slot) * SHM_V + (widu * NI + i_) * 1024), 16, 0, 0); } } while (0)
  f32x16 pA0 = f32x16{}, pA1 = f32x16{}, pB0 = f32x16{}, pB1 = f32x16{}; bf16x8 pa0 = bf16x8{}, pa1 = bf16x8{}, pa2 = bf16x8{}, pa3 = bf16x8{};
  const bool wact = !meta || widu < 2;
  DMA(0, 0); DMA(1, 1); DMA(2, 2);
  asm volatile("s_waitcnt vmcnt(0)" ::: "memory"); __syncthreads();
  if (wact) { qkt<KW, true>(pA0, pA1, K_lds, qr, negm, r32, hi, cboff); partialSM<false>(pA0, mref); }
  int bprev = 0, bcur = 1, bnext = 2;
#define HALFSTEP(X0, X1, Y0, Y1, LAST) do { \
    SBAR(); if (wact) { qkt<KW, true>(X0, X1, K_lds + bcur * SHM_K, qr, negm, r32, hi, cboff); \
    if (LAST) { asm volatile("" ::: "memory"); _Pragma("unroll") for (int r = 8; r < 16; ++r) X0[r] = -1e30f; _Pragma("unroll") for (int r = 0; r < 16; ++r) X1[r] = -1e30f; } \
    finishSM<false, ISB || !AONES>(Y0, Y1, mref, l_reg, pa0, pa1, pa2, pa3); } SBAR(); \
    if (wact) { pv_all<NCB>(o, lacc, vb0 + bprev * SHM_V, pa0, pa1, pa2, pa3); partialSM<false>(X0, mref); } \
    asm volatile("s_waitcnt vmcnt(0)" ::: "memory"); __syncthreads(); DMA(t + 2, bprev); \
    { const int t_ = bprev; bprev = bcur; bcur = bnext; bnext = t_; } } while (0)
  for (int t = 1; t < NT; t += 2) {
    { HALFSTEP(pB0, pB1, pA0, pA1, false); }
    { const int t0_ = t; const int t = t0_ + 1; HALFSTEP(pA0, pA1, pB0, pB1, __builtin_expect(t + 1 == NT, 0)); }
  }
  if (wact) { finishSM<false, ISB || !AONES>(pA0, pA1, mref, l_reg, pa0, pa1, pa2, pa3); SBAR();
  pv_all<NCB>(o, lacc, vb0 + bprev * SHM_V, pa0, pa1, pa2, pa3); }
  asm volatile("s_waitcnt vmcnt(0)" ::: "memory"); __syncthreads();
  float rli[16];
  if constexpr (ISB || !AONES) {
    { auto rr = __builtin_amdgcn_permlane32_swap(__float_as_uint(l_reg), __float_as_uint(l_reg), false, false); l_reg = __uint_as_float(rr[0]) + __uint_as_float(rr[1]); }
    if (hi == 0) li_l[r32] = l_reg; asm volatile("s_waitcnt lgkmcnt(0)" ::: "memory");
#pragma unroll
    for (int r = 0; r < 16; ++r) rli[r] = __builtin_amdgcn_rcpf(li_l[crow(r, hi)]);
  } else {
#pragma unroll
    for (int r = 0; r < 16; ++r) rli[r] = __builtin_amdgcn_rcpf(lacc[r]);
  }
  const int i2 = lane >> 1, half = lane & 1;
  int pos2, hq2; bool valid2; rowmap<ISB>(meta, hidx, qt, wid, i2, pos2, hq2, valid2);
  if constexpr (!ISB) {
    float* stg = (float*)(lds + LDS_STG + wid * STG_WAVE);
#pragma unroll
    for (int r = 0; r < 16; ++r)
#pragma unroll
      for (int d0 = 0; d0 < 2; ++d0) stg[crow(r, hi) * 68 + d0 * 32 + r32] = o[d0][r] * rli[r];
    asm volatile("s_waitcnt lgkmcnt(0)" ::: "memory");
    bf16* Op = A.mix + (size_t)(seqbase + pos2) * 1024 + hq2 * 64 + half * 32;
#pragma unroll
    for (int c = 0; c < 4; ++c) { const f32x4 a = *(const f32x4*)(stg + i2 * 68 + half * 32 + c * 8), b = *(const f32x4*)(stg + i2 * 68 + half * 32 + c * 8 + 4);
      u32x4 w = {cvtpk(a[0], a[1]), cvtpk(a[2], a[3]), cvtpk(b[0], b[1]), cvtpk(b[2], b[3])}; if (valid2) *(u32x4*)(Op + c * 8) = w; }
  } else {
    float* reg = (float*)(lds + LDS_STG + (wid & ~1) * STG_WAVE);
#pragma unroll
    for (int d = 0; d < 4; ++d)
#pragma unroll
      for (int r = 0; r < 16; ++r) o[d][r] *= rli[r];
    if (comp == 1) {
#pragma unroll
      for (int d = 0; d < 4; ++d)
#pragma unroll
        for (int r = 0; r < 16; ++r) reg[(d * 16 + r) * 64 + lane] = o[d][r];
    }
    __syncthreads();
    if (comp == 0) {
#pragma unroll
      for (int d = 0; d < 4; ++d)
#pragma unroll
        for (int r = 0; r < 16; ++r) o[d][r] -= lam * reg[(d * 16 + r) * 64 + lane];
      asm volatile("s_waitcnt lgkmcnt(0)" ::: "memory");
#pragma unroll
      for (int d = 0; d < 4; ++d)
#pragma unroll
        for (int r = 0; r < 16; ++r) reg[crow(r, hi) * 132 + d * 32 + r32] = o[d][r];
      asm volatile("s_waitcnt lgkmcnt(0)" ::: "memory");
      f32x4 v[16]; float ss = 0.f;
#pragma unroll
      for (int c = 0; c < 16; ++c) { v[c] = *(const f32x4*)(reg + i2 * 132 + half * 64 + c * 4); ss += (v[c][0] * v[c][0] + v[c][1] * v[c][1]) + (v[c][2] * v[c][2] + v[c][3] * v[c][3]); }
      ss += __shfl_xor(ss, 1);
      const float rs = rsqrtf(ss * (1.0f / 128.0f) + NORM_EPS) * 0.8f;
      bf16* Op = A.mix + (size_t)(seqbase + pos2) * 1024 + 512 + hq2 * 128 + half * 64;
      const float* gp = A.gsub + half * 64;
#pragma unroll
      for (int c = 0; c < 8; ++c) { const f32x4 g0 = *(const f32x4*)(gp + c * 8), g1 = *(const f32x4*)(gp + c * 8 + 4); const f32x4 a = v[2 * c] * g0 * rs, b = v[2 * c + 1] * g1 * rs;
        u32x4 w = {cvtpk(a[0], a[1]), cvtpk(a[2], a[3]), cvtpk(b[0], b[1]), cvtpk(b[2], b[3])}; if (valid2) *(u32x4*)(Op + c * 8) = w; }
    }
  }
#undef DMA
#undef HALFSTEP
}
#undef SBAR

constexpr int U1 = 32, U2 = 16, U3 = 1024, U4 = 1024, U5 = 128, U6 = 64, U7 = 2048, U8 = 2048, NUNITS = U1 + U2 + U3 + U4 + U5 + U6 + U7 + U8;
__device__ __forceinline__ void attn_phase(const AttnArgs& A, char* lds, unsigned* counter, float lam) {
  volatile int* s_unit = (volatile int*)(lds + LDS_UNIT);
  for (;;) {
    __syncthreads();
    if (threadIdx.x == 0) *s_unit = (int)atomicAdd(counter, 1u);
    __syncthreads();
    int u = *s_unit;
    if (u >= NUNITS) break;
    int isB, meta, grp, seq, h, qt = 0;
    if (u < U1) { isB = 1; meta = 1; grp = 0; seq = u >> 2; h = u & 3; }
    else if ((u -= U1) < U2) { isB = 0; meta = 1; grp = 0; seq = u >> 1; h = u & 1; }
    else if ((u -= U2) < U3) { isB = 1; meta = 0; grp = 0; seq = u >> 7; h = (u & 127) >> 5; qt = u & 31; }
    else if ((u -= U3) < U4) { isB = 0; meta = 0; grp = 0; seq = u >> 7; h = (u & 127) >> 4; qt = u & 15; }
    else if ((u -= U4) < U5) { isB = 1; meta = 1; grp = 1; seq = u >> 2; h = u & 3; }
    else if ((u -= U5) < U6) { isB = 0; meta = 1; grp = 1; seq = u >> 1; h = u & 1; }
    else if ((u -= U6) < U7) { isB = 1; meta = 0; grp = 1; seq = u >> 6; h = (u & 63) >> 4; qt = u & 15; }
    else { u -= U7; isB = 0; meta = 0; grp = 1; seq = u >> 6; h = (u & 63) >> 3; qt = u & 7; }
    const int seqbase = grp ? ROWS_P + seq * L_S : seq * L_P, L = grp ? L_S : L_P;
    const int sidx = grp ? NSEQ_P + seq : seq;
#if !defined(ONLY_A)
    if (isB) attn_unit<true>(A, seqbase, sidx, L, h, qt, meta, lds, lam);
#endif
#if !defined(ONLY_B)
    if (!isB) {
      if (!meta) {
        const size_t qrow = (size_t)(seqbase + 16 + 256 * qt);
        ab::attn_unit<8>(A.QA + qrow * 512 + h * 64, A.KA + (size_t)seqbase * 128 + (h >> 2) * 64, A.VA + (size_t)seqbase * 128 + (h >> 2) * 64, A.mix + qrow * 1024 + h * 64, (L + 127) / 128 * 2, lds);
      } else attn_unit<false>(A, seqbase, sidx, L, h, qt, meta, lds, lam);
    }
#endif
  }
}
}
constexpr size_t WS_CTL = 0;
constexpr size_t WS_RSS1 = 4096, WS_RSS2 = WS_RSS1 + (size_t)MPAD * 4;
constexpr size_t WS_TAB = 1u << 20;
constexpr size_t TAB_BYTES = (size_t)L_P * 32 * 4;
constexpr size_t WS_W = 4u << 20;
constexpr size_t WS_WIN = WS_W, WS_WO = WS_WIN + (size_t)INC * DM * 2, WS_WG = WS_WO + (size_t)DM * DM * 2, WS_WU = WS_WG + (size_t)FF * DM * 2, WS_WD = WS_WU + (size_t)FF * DM * 2;
constexpr size_t WS_BIG = 28u << 20;
static_assert(WS_WD + (size_t)FF * DM * 2 <= WS_BIG && WS_RSS2 + (size_t)MPAD * 4 <= WS_TAB && WS_TAB + 4 * TAB_BYTES <= WS_W, "ws map");
constexpr size_t WS_HB = WS_BIG;
constexpr size_t WS_ACT = WS_HB + (size_t)MPAD * DM * 2;
constexpr size_t WS_GLO = WS_ACT + (size_t)MPAD * FF * 2;
constexpr size_t WS_END = WS_GLO + (size_t)MPAD * 1280 * 2 + 65536;
constexpr size_t WS_XN = WS_ACT;
constexpr size_t WS_QA = WS_XN + (size_t)MPAD * DM * 2, WS_KA = WS_QA + (size_t)MPAD * 512 * 2, WS_VA = WS_KA + (size_t)MPAD * 128 * 2,
                 WS_QB = WS_VA + (size_t)MPAD * 128 * 2, WS_KB = WS_QB + (size_t)MPAD * 512 * 2, WS_VB = WS_KB + (size_t)MPAD * 512 * 2;
static_assert(WS_VB + (size_t)MPAD * 512 * 2 <= WS_END, "ws map 2");
static_assert((size_t)MPAD * 1536 * 2 <= (size_t)OUT_ROWS * DM * 4, "Ghi fits in d_out");
constexpr int LDS_BYTES = 147456;

#define LAS __attribute__((address_space(3)))
typedef unsigned short bf16;
typedef float f32x4 __attribute__((ext_vector_type(4)));
typedef unsigned v4u __attribute__((ext_vector_type(4)));
typedef unsigned v2u __attribute__((ext_vector_type(2)));
__device__ __forceinline__ unsigned pk2(float lo, float hi) { return pg8::cvt_pk_bf16(lo, hi); }
__device__ __forceinline__ float wave_sum(float v) {
#pragma unroll
    for (int o = 1; o < 64; o <<= 1) v += __shfl_xor(v, o);
    return v;
}
__device__ const double INVB[32] = {1.0, 0.7498942093324559, 0.5623413251903491, 0.4216965034285822, 0.31622776601683794, 0.23713737056616552, 0.1778279410038923, 0.1333521432163324,
    0.1, 0.07498942093324558, 0.05623413251903491, 0.042169650342858224, 0.03162277660168379, 0.023713737056616554, 0.01778279410038923, 0.01333521432163324,
    0.01, 0.007498942093324558, 0.005623413251903491, 0.004216965034285823, 0.0031622776601683794, 0.0023713737056616554, 0.0017782794100389228, 0.001333521432163324,
    0.001, 0.0007498942093324559, 0.0005623413251903491, 0.00042169650342858224, 0.00031622776601683794, 0.00023713737056616554, 0.00017782794100389227, 0.0001333521432163324};
__device__ __forceinline__ void sincos_d(double x, float& s, float& c) {
    const double k = rint(x * 0.6366197723675814);
    double r = fma(-k, 1.5707963267948966, x); r = fma(-k, 6.123233995736766e-17, r);
    const int q = ((int)k) & 3; const double r2 = r * r;
    const double sp = r * (1.0 + r2 * (-1.0 / 6 + r2 * (1.0 / 120 + r2 * (-1.0 / 5040 + r2 * (1.0 / 362880 + r2 * (-1.0 / 39916800 + r2 * (1.0 / 6227020800.0)))))));
    const double cp = 1.0 + r2 * (-0.5 + r2 * (1.0 / 24 + r2 * (-1.0 / 720 + r2 * (1.0 / 40320 + r2 * (-1.0 / 3628800 + r2 * (1.0 / 479001600 + r2 * (-1.0 / 87178291200.0)))))));
    const double ss = (q & 1) ? cp : sp, cc = (q & 1) ? sp : cp;
    s = (float)((q & 2) ? -ss : ss); c = (float)(((q + 1) & 2) ? -cc : cc);
}
__device__ __forceinline__ void transpose_item(const float* W, int K, int N, bf16* WT, const float* gs, bool perm, LAS float* scr, int item, int lane) {
    const int nblk = N / 32, kb = item / nblk, nb = item % nblk, k0 = 64 * kb, n0 = 32 * nb;
#pragma unroll 8
    for (int i = 0; i < 32; ++i) { const int kk = 2 * i + (lane >> 5); float v = W[(size_t)(k0 + kk) * N + n0 + (lane & 31)]; if (gs) v *= gs[k0 + kk]; scr[kk * 33 + (lane & 31)] = v; }
    asm volatile("s_waitcnt lgkmcnt(0)" ::: "memory");
    const int c = lane & 7;
    const int t0 = perm ? ((n0 >> 8) * 256 + ((n0 >> 5) & 1) * 128 + ((n0 >> 6) & 3) * 32) : n0;
#pragma unroll
    for (int j = 0; j < 4; ++j) { const int n = (lane >> 3) + 8 * j; const LAS float* s = scr + (8 * c) * 33 + n;
        v4u o; o.x = pk2(s[0 * 33], s[1 * 33]); o.y = pk2(s[2 * 33], s[3 * 33]); o.z = pk2(s[4 * 33], s[5 * 33]); o.w = pk2(s[6 * 33], s[7 * 33]);
        *(v4u*)(WT + (size_t)(t0 + n) * K + k0 + 8 * c) = o; }
    asm volatile("s_waitcnt lgkmcnt(0)" ::: "memory");
}

#define XB_TMO      128
#define XB_XCNT(j)  (256  + 64 * (j))
#define XB_XSUB(j)  (1280 + 64 * (j))
#define XB_XGEN(j)  (2304 + 64 * (j))
#define XB_TOP      3328
#define XB_TOPGEN   3392
#define XCD_BAR_WORDS 3456
#define XB_SPIN_CAP (1u << 18)

__device__ __forceinline__ unsigned xb_ld(unsigned* p)              { return __hip_atomic_load(p, __ATOMIC_RELAXED, __HIP_MEMORY_SCOPE_AGENT); }
__device__ __forceinline__ unsigned xb_add(unsigned* p, unsigned v) { return __hip_atomic_fetch_add(p, v, __ATOMIC_RELAXED, __HIP_MEMORY_SCOPE_AGENT); }
__device__ __forceinline__ unsigned xb_xcc_id() { return (unsigned)__builtin_amdgcn_s_getreg((3 << 11) | 20) & 0xFu; }
#define XB_SPIN(cond, bar) do { unsigned _sp = 0; while (cond) { __builtin_amdgcn_s_sleep(1); \
    if ((++_sp & 255u) == 0u) { if (xb_ld(&(bar)[XB_TMO])) break; if (_sp > XB_SPIN_CAP) { atomicAdd(&(bar)[XB_TMO], 1u); break; } } } } while (0)

struct XcdBarrier {
    unsigned* bar; unsigned x;
    volatile LAS unsigned* st;
};

__device__ __forceinline__ XcdBarrier xcd_barrier_post(unsigned* bar, volatile LAS unsigned* st) {
    XcdBarrier b; b.bar = bar; b.x = xb_xcc_id(); b.st = st;
    if (threadIdx.x == 0) (void)xb_add(&bar[XB_XCNT(b.x)], 1u);
    return b;
}
__device__ __forceinline__ void xcd_barrier_complete(unsigned* bar, unsigned x, unsigned& nloc, unsigned& nx) {
    const unsigned G = gridDim.x * gridDim.y * gridDim.z;
    unsigned sum, cnt, mine, sp = 0u;
    for (;;) {
        sum = 0u; cnt = 0u; mine = 0u;
#pragma unroll
        for (unsigned j = 0; j < 16; ++j) { const unsigned c = xb_ld(&bar[XB_XCNT(j)]); sum += c; cnt += (c > 0u) ? 1u : 0u; mine = (j == x) ? c : mine; }
        if (sum == G) break;
        __builtin_amdgcn_s_sleep(1);
        if ((++sp & 255u) == 0u) { if (xb_ld(&bar[XB_TMO])) break; if (sp > XB_SPIN_CAP) { atomicAdd(&bar[XB_TMO], 1u); break; } }
    }
    nloc = mine > 0u ? mine : 1u; nx = cnt > 0u ? cnt : 1u;
}

__device__ __forceinline__ void xcd_barrier(const XcdBarrier& b) {
    asm volatile("s_waitcnt vmcnt(0)" ::: "memory");
    __syncthreads();
    if (threadIdx.x == 0) {
        unsigned* bar = b.bar;
        __builtin_amdgcn_s_waitcnt(0);
        unsigned nloc = b.st[0], nx = b.st[1];
        if (nloc == 0u) { xcd_barrier_complete(bar, b.x, nloc, nx); b.st[0] = nloc; b.st[1] = nx; }
        const unsigned old = xb_add(&bar[XB_XSUB(b.x)], 1u);
        const unsigned gen = old / nloc;
        if (old + 1u == (gen + 1u) * nloc) {
            __builtin_amdgcn_fence(__ATOMIC_RELEASE, "agent");
            asm volatile("s_waitcnt vmcnt(0)" ::: "memory");
            const unsigned og = xb_add(&bar[XB_TOP], 1u);
            const unsigned tg = og / nx;
            if (og + 1u == (tg + 1u) * nx) xb_add(&bar[XB_TOPGEN], 1u);
            else XB_SPIN(xb_ld(&bar[XB_TOPGEN]) == tg, bar);
            __builtin_amdgcn_fence(__ATOMIC_ACQUIRE, "agent");
            xb_add(&bar[XB_XGEN(b.x)], 1u);
            asm volatile("s_waitcnt vmcnt(0)" ::: "memory");
        } else {
            XB_SPIN(xb_ld(&bar[XB_XGEN(b.x)]) == gen, bar);
            __builtin_amdgcn_fence(__ATOMIC_ACQUIRE, "agent");
            asm volatile("s_waitcnt vmcnt(0)" ::: "memory");
        }
    }
    __syncthreads();
}

constexpr size_t WS_XBAR = 800u << 10;
static_assert(WS_XBAR >= WS_RSS2 + (size_t)MPAD * 4 && WS_XBAR + XCD_BAR_WORDS * 4 <= WS_TAB, "barrier words");
#ifndef PH_MASK
#define PH_MASK 0xff
#endif
struct Args { const float* in[20]; float* out; unsigned char* ws; };

__global__ void __launch_bounds__(512, 2) mega_fwd(Args a) {
    extern __shared__ __attribute__((aligned(16))) unsigned char lds[];
    cg::grid_group grid = cg::this_grid();
    volatile LAS unsigned* xb_st = (volatile LAS unsigned*)((LAS unsigned char*)lds + (LDS_BYTES - 128));
    if (threadIdx.x < 2) xb_st[threadIdx.x] = 0u;
    __syncthreads();
#define TID_DEFS const int tid = threadIdx.x, lane = tid & 63, wave = __builtin_amdgcn_readfirstlane(tid >> 6); const int G = gridDim.x, gw = blockIdx.x * 8 + wave, NGW = G * 8; (void)lane; (void)gw; (void)NGW; (void)G
#define WSP(T, off) ((T*)(a.ws + (off)))
#define Win_t WSP(bf16, WS_WIN)
#define Wo_t WSP(bf16, WS_WO)
#define Wg_t WSP(bf16, WS_WG)
#define Wu_t WSP(bf16, WS_WU)
#define Wd_t WSP(bf16, WS_WD)
#define XN WSP(bf16, WS_XN)
#define MIX WSP(bf16, WS_XN)
#define HB WSP(bf16, WS_HB)
#define ACT WSP(bf16, WS_ACT)
#define GLO WSP(bf16, WS_GLO)
#define GHI ((bf16*)a.out)
#define QA WSP(bf16, WS_QA)
#define KA WSP(bf16, WS_KA)
#define VA WSP(bf16, WS_VA)
#define QB WSP(bf16, WS_QB)
#define KB WSP(bf16, WS_KB)
#define VB WSP(bf16, WS_VB)
#define cosA WSP(float, WS_TAB)
#define sinA WSP(float, WS_TAB + TAB_BYTES)
#define cosB WSP(float, WS_TAB + 2 * TAB_BYTES)
#define sinB WSP(float, WS_TAB + 3 * TAB_BYTES)
#define rss1 WSP(float, WS_RSS1)
#define rss2 WSP(float, WS_RSS2)
#define ctl WSP(unsigned, WS_CTL)
#define KMAX2 WSP(float, WS_CTL + 2048)

#if PH_MASK & (1 << 0)
    {
        TID_DEFS;
        LAS float* scr = (LAS float*)((LAS unsigned char*)lds + wave * 16384);
        constexpr int I_IN = (DM / 64) * (INC / 32), I_O = (DM / 64) * (DM / 32), I_G = (DM / 64) * (FF / 32), I_D = (FF / 64) * (DM / 32);
        constexpr int NITEMS = I_IN + I_O + 2 * I_G + I_D;
        for (int it = gw; it < NITEMS; it += NGW) {
            int r = it;
            if (r < I_IN) { transpose_item(a.in[4], DM, INC, Win_t, nullptr, true, scr, r, lane); continue; } r -= I_IN;
            if (r < I_O) { transpose_item(a.in[12], DM, DM, Wo_t, nullptr, false, scr, r, lane); continue; } r -= I_O;
            if (r < I_G) { transpose_item(a.in[14], DM, FF, Wg_t, a.in[13], false, scr, r, lane); continue; } r -= I_G;
            if (r < I_G) { transpose_item(a.in[15], DM, FF, Wu_t, a.in[13], false, scr, r, lane); continue; } r -= I_G;
            transpose_item(a.in[18], FF, DM, Wd_t, nullptr, false, scr, r, lane);
        }
        const f32x4* gm = (const f32x4*)a.in[3] + lane;
        const f32x4 g0 = gm[0], g1 = gm[64], g2 = gm[128], g3 = gm[192];
        static_assert(MPAD % 4 == 0, "four rows per wave trip");
        for (int m0 = gw * 4; m0 < MPAD; m0 += NGW * 4) {
            f32x4 v[4][4];
#pragma unroll
            for (int r = 0; r < 4; ++r) {
                const int m = m0 + r < MROWS ? m0 + r : 0;
                const RowInfo ri = rowinfo(m);
                const float* hp = ri.pos < 16 ? a.in[2] + (size_t)ri.pos * DM : (ri.grp ? a.in[1] : a.in[0]) + (size_t)ri.xrow * DM;
                const f32x4* xr = (const f32x4*)hp + lane;
#pragma unroll
                for (int j = 0; j < 4; ++j) v[r][j] = xr[64 * j];
            }
#pragma unroll
            for (int r = 0; r < 4; ++r) {
                float s2 = 0.f;
#pragma unroll
                for (int j = 0; j < 4; ++j) s2 += (v[r][j].x * v[r][j].x + v[r][j].y * v[r][j].y) + (v[r][j].z * v[r][j].z + v[r][j].w * v[r][j].w);
                const float rstd = (m0 + r < MROWS) ? rsqrtf(wave_sum(s2) * (1.f / DM) + NORM_EPS) : 0.f;
                unsigned long long* o8 = (unsigned long long*)(XN + (size_t)(m0 + r) * DM) + lane;
                const f32x4 y0 = v[r][0] * g0 * rstd, y1 = v[r][1] * g1 * rstd, y2 = v[r][2] * g2 * rstd, y3 = v[r][3] * g3 * rstd;
                o8[0] = (unsigned long long)pk2(y0.x, y0.y) | ((unsigned long long)pk2(y0.z, y0.w) << 32);
                o8[64] = (unsigned long long)pk2(y1.x, y1.y) | ((unsigned long long)pk2(y1.z, y1.w) << 32);
                o8[128] = (unsigned long long)pk2(y2.x, y2.y) | ((unsigned long long)pk2(y2.z, y2.w) << 32);
                o8[192] = (unsigned long long)pk2(y3.x, y3.y) | ((unsigned long long)pk2(y3.z, y3.w) << 32);
            }
        }
        const int gt = blockIdx.x * 512 + tid, NGT = G * 512;
        for (int e = gt; e < L_P * 32; e += NGT) {
            const int pos = e >> 5, i = e & 31;
            float s, c;
            sincos_d((double)pos * INVB[i], s, c); cosB[e] = c; sinB[e] = s;
            if (pos < 16) { cosA[e] = 1.f; sinA[e] = 0.f; }
            else { const int t = pos - 16; const int rc = i < 16 ? (t >> 6) : (t & 63); sincos_d((double)rc * INVB[2 * (i & 15)], s, c); cosA[e] = c; sinA[e] = s; }
        }
        for (int e = gt; e < 2 * MPAD; e += NGT) rss1[e] = 0.f;
        if (gt == 0) ctl[0] = 0u;
        if (gt < 400) KMAX2[gt] = 0.f;
        for (int e = gt; e < XCD_BAR_WORDS; e += NGT) WSP(unsigned, WS_XBAR)[e] = 0u;
    }
#endif
    grid.sync();
    const XcdBarrier xb = xcd_barrier_post(WSP(unsigned, WS_XBAR), xb_st);

#if PH_MASK & (1 << 1)
    {
        TID_DEFS;
        pg8::Gemm g{XN, Win_t, MPAD, INC, DM}; pg8::StaticOrder S; S.init(MPAD, INC, G, (int)blockIdx.x);
        pg8::EpiQKV E{QA, KA, VA, QB, KB, VB, cosA, sinA, cosB, sinB, a.in[5], a.in[6], KMAX2};
#if defined(DUP_P1)
        int nrep = 2; asm volatile("" : "+s"(nrep));
        for (int rep = 0; rep < nrep; ++rep)
#endif
        pg8::gemm_phase<pg8::EpiQKV, pg8::StaticOrder, true, true>((LAS unsigned char*)lds, g, S, E);
    }
#endif
    xcd_barrier(xb);

#if PH_MASK & (1 << 2)
    {
        TID_DEFS;
        const float s1 = wave_sum(a.in[7][lane] * a.in[8][lane]), s2 = wave_sum(a.in[9][lane] * a.in[10][lane]);
        const float lam = __expf(s1) - __expf(s2) + 0.2f;
        const att::AttnArgs A{QA, KA, VA, QB, KB, VB, MIX, a.in[11], KMAX2};
        att::attn_phase(A, (char*)lds, ctl, lam);
    }
#endif
    xcd_barrier(xb);

#if PH_MASK & (1 << 3)
    {
        TID_DEFS;
        pg8::Gemm g{MIX, Wo_t, MPAD, DM, DM}; pg8::StaticOrder S; S.init(MPAD, DM, G, (int)blockIdx.x);
        pg8::EpiWo E{a.in[0], a.in[1], a.in[2], HB, rss1};
        pg8::gemm_phase<pg8::EpiWo, pg8::StaticOrder, true, true>((LAS unsigned char*)lds, g, S, E);
    }
#endif
    xcd_barrier(xb);

#if PH_MASK & (1 << 4)
    {
        TID_DEFS;
        pg8::Gemm g{HB, Wg_t, MPAD, FF, DM}; pg8::StaticOrder S; S.init(MPAD, FF, G, (int)blockIdx.x);
        pg8::EpiGate E{GLO, GHI, rss1};
#if defined(DUP_P4)
        int nrep = 2; asm volatile("" : "+s"(nrep));
        for (int rep = 0; rep < nrep; ++rep)
#endif
        pg8::gemm_phase<pg8::EpiGate, pg8::StaticOrder, true, true>((LAS unsigned char*)lds, g, S, E);
    }
#endif
    xcd_barrier(xb);

#if PH_MASK & (1 << 5)
    {
        TID_DEFS;
        pg8::Gemm g{HB, Wu_t, MPAD, FF, DM}; pg8::StaticOrder S; S.init(MPAD, FF, G, (int)blockIdx.x);
        pg8::EpiUp E{GLO, GHI, rss1, a.in[16], a.in[17], ACT};
#if defined(DUP_P5)
        int nrep = 2; asm volatile("" : "+s"(nrep));
        for (int rep = 0; rep < nrep; ++rep)
#endif
        pg8::gemm_phase<pg8::EpiUp, pg8::StaticOrder, true, true>((LAS unsigned char*)lds, g, S, E);
    }
#endif
    xcd_barrier(xb);

#if PH_MASK & (1 << 6)
    {
        TID_DEFS;
        pg8::Gemm g{ACT, Wd_t, MPAD, DM, FF}; pg8::StaticOrder S; S.init(MPAD, DM, G, (int)blockIdx.x);
        pg8::EpiDown E{HB, a.out, rss2};
        pg8::gemm_phase<pg8::EpiDown, pg8::StaticOrder, true, true>((LAS unsigned char*)lds, g, S, E);
    }
#endif
    xcd_barrier(xb);

#if PH_MASK & (1 << 7)
    {
        TID_DEFS;
        const f32x4* gf = (const f32x4*)a.in[19] + lane;
        const f32x4 g0 = gf[0], g1 = gf[64], g2 = gf[128], g3 = gf[192];
        static_assert(OUT_ROWS % 4 == 0, "four rows per wave trip");
        for (int m0 = gw * 4; m0 < OUT_ROWS; m0 += NGW * 4) {
            f32x4 v[4][4]; float rs[4];
#pragma unroll
            for (int r = 0; r < 4; ++r) { const f32x4* xr = (const f32x4*)(a.out + (size_t)(m0 + r) * DM) + lane; rs[r] = rss2[m0 + r];
#pragma unroll
                for (int j = 0; j < 4; ++j) v[r][j] = xr[64 * j]; }
#pragma unroll
            for (int r = 0; r < 4; ++r) { f32x4* xr = (f32x4*)(a.out + (size_t)(m0 + r) * DM) + lane; const float rstd = rsqrtf(rs[r] * (1.f / DM) + NORM_EPS);
                xr[0] = v[r][0] * g0 * rstd; xr[64] = v[r][1] * g1 * rstd; xr[128] = v[r][2] * g2 * rstd; xr[192] = v[r][3] * g3 * rstd; }
        }
    }
#endif
}

extern "C" void kernel_launch(void* const* d_in, const int* in_sizes, int n_in, void* d_out, int out_size, void* d_ws, size_t ws_size, hipStream_t stream) {
    static int grid = 0;
    if (grid == 0) {
        if (n_in != 20 || out_size != OUT_ROWS * DM || ws_size < WS_END) { fprintf(stderr, "kernel_launch: unexpected shapes n_in %d out %d ws %zu (need %zu)\n", n_in, out_size, ws_size, (size_t)WS_END); grid = -1; return; }
        int dev = 0, cus = 0, per_cu = 0;
        hipGetDevice(&dev); hipDeviceGetAttribute(&cus, hipDeviceAttributeMultiprocessorCount, dev);
        hipFuncSetAttribute((const void*)mega_fwd, hipFuncAttributeMaxDynamicSharedMemorySize, LDS_BYTES);
        hipOccupancyMaxActiveBlocksPerMultiprocessor(&per_cu, (const void*)mega_fwd, 512, LDS_BYTES);
        if (per_cu < 1) { fprintf(stderr, "kernel_launch: occupancy query says %d blocks/CU\n", per_cu); per_cu = 1; }
        (void)hipGetLastError();
        grid = cus * 1;
    }
    if (grid < 0) return;
    Args a{};
    for (int i = 0; i < 20; ++i) a.in[i] = (const float*)d_in[i];
    a.out = (float*)d_out; a.ws = (unsigned char*)d_ws;
    void* args[] = {&a};
    hipError_t e = hipLaunchCooperativeKernel((const void*)mega_fwd, dim3(grid), dim3(512), args, LDS_BYTES, stream);
    if (e != hipSuccess) fprintf(stderr, "cooperative launch failed: %s (grid %d)\n", hipGetErrorString(e), grid);
}
```
